# Optimizing an MI355X kernel written in HIP

```python
import jax, jax.numpy as jnp
from jax import lax
import numpy as np


D_MODEL = 1024
BATCH = 16
SEQ = 2048
DEPTH = 4

CHUNK = 64
N_MIXERS = 2
N_SB_LAYERS = (DEPTH + 1) // 2
N_RG_LAYERS = DEPTH // 2

SB_HEADS = 16
SB_HEAD_DIM = D_MODEL // SB_HEADS
Q_BLOCK = 128

RG_WIDTH = D_MODEL
RG_BLOCKS = 16
RG_BLOCK_DIM = RG_WIDTH // RG_BLOCKS
RG_CONV = 4
RG_C = 8.0

D_FF = 4 * D_MODEL
EPS = 1e-6

kernel_name = 'hybrid_stickbreak_rglru_encoder'


def rms_norm(x, g):
    xf = x.astype(jnp.float32)
    y = xf * lax.rsqrt(jnp.mean(xf * xf, axis=-1, keepdims=True) + EPS)
    return (y * g.astype(jnp.float32)).astype(x.dtype)


def stick_breaking_attention(h, w_qkv, w_o):
    B, S, _ = h.shape
    qkv = (h @ w_qkv).reshape(B, S, 3, SB_HEADS, SB_HEAD_DIM)
    q = qkv[:, :, 0].transpose(0, 2, 1, 3)
    k = qkv[:, :, 1].transpose(0, 2, 1, 3)
    v = qkv[:, :, 2].transpose(0, 2, 1, 3)
    scale = SB_HEAD_DIM ** -0.5
    outs = []
    for start in range(0, S, Q_BLOCK):
        end = start + Q_BLOCK
        qb = q[:, :, start:end]
        kb = k[:, :, :end]
        vb = v[:, :, :end]
        z = jnp.einsum('bhqd,bhkd->bhqk', qb, kb).astype(jnp.float32) * scale
        q_pos = start + jnp.arange(Q_BLOCK)[:, None]
        k_pos = jnp.arange(end)[None, :]
        mask = k_pos < q_pos
        log_keep = jnp.where(mask, jax.nn.log_sigmoid(-z), 0.0)
        after = lax.cumsum(log_keep, axis=3, reverse=True) - log_keep
        w = jnp.where(mask, jnp.exp(jax.nn.log_sigmoid(z) + after), 0.0)
        outs.append(jnp.einsum('bhqk,bhkd->bhqd', w.astype(vb.dtype), vb))
    o = jnp.concatenate(outs, axis=2).transpose(0, 2, 1, 3).reshape(B, S, D_MODEL)
    return o @ w_o


def causal_depthwise_conv(x, w, b):
    S = x.shape[1]
    xp = jnp.pad(x, ((0, 0), (RG_CONV - 1, 0), (0, 0)))
    y = b
    for tap in range(RG_CONV):
        y = y + xp[:, tap:tap + S] * w[tap]
    return y


def lru_combine(e1, e2):
    a1, b1 = e1
    a2, b2 = e2
    return a1 * a2, a2 * b1 + b2


def rglru_block(h, w_in, conv_w, conv_b, w_a, b_a, w_x, b_x, lam, w_o):
    B, S, _ = h.shape
    proj = h @ w_in
    gate = jax.nn.gelu(proj[..., :RG_WIDTH])
    xc = causal_depthwise_conv(proj[..., RG_WIDTH:], conv_w, conv_b)
    xh = xc.reshape(B, S, RG_BLOCKS, RG_BLOCK_DIM)
    r = jax.nn.sigmoid(jnp.einsum('bshi,hij->bshj', xh, w_a).reshape(B, S, RG_WIDTH) + b_a)
    i = jax.nn.sigmoid(jnp.einsum('bshi,hij->bshj', xh, w_x).reshape(B, S, RG_WIDTH) + b_x)
    log_a = (-RG_C * r.astype(jnp.float32)) * jax.nn.softplus(-lam.astype(jnp.float32))
    a = jnp.exp(log_a)
    mult = jnp.sqrt(-jnp.expm1(2.0 * log_a))
    bterm = mult * (i * xc).astype(jnp.float32)
    _, hs = lax.associative_scan(lru_combine, (a, bterm), axis=1)
    y = hs.astype(h.dtype) * gate
    return y @ w_o


def squared_relu_mlp(h, w1, w2):
    u = jax.nn.relu(h @ w1)
    return (u * u) @ w2


def setup_inputs(seed: int = 0) -> dict:
    key = jax.random.key(seed)
    ks = jax.random.split(key, 20)
    f32 = jnp.float32
    res_scale = (2.0 * DEPTH) ** -0.5
    x = jax.random.normal(ks[0], (BATCH, SEQ, D_MODEL), f32)
    norm_mix = 1.0 + 0.02 * jax.random.normal(ks[1], (DEPTH, D_MODEL), f32)
    norm_mlp = 1.0 + 0.02 * jax.random.normal(ks[2], (DEPTH, D_MODEL), f32)
    mlp_w1 = jax.random.normal(ks[3], (DEPTH, D_MODEL, D_FF), f32) * D_MODEL ** -0.5
    mlp_w2 = jax.random.normal(ks[4], (DEPTH, D_FF, D_MODEL), f32) * (D_FF ** -0.5 * res_scale)
    sb_w_qkv = jax.random.normal(ks[5], (N_SB_LAYERS, D_MODEL, 3 * D_MODEL), f32) * D_MODEL ** -0.5
    sb_w_o = jax.random.normal(ks[6], (N_SB_LAYERS, D_MODEL, D_MODEL), f32) * (D_MODEL ** -0.5 * res_scale)
    rg_w_in = jax.random.normal(ks[7], (N_RG_LAYERS, D_MODEL, 2 * RG_WIDTH), f32) * D_MODEL ** -0.5
    rg_conv_w = jax.random.normal(ks[8], (N_RG_LAYERS, RG_CONV, RG_WIDTH), f32) * RG_CONV ** -0.5
    rg_conv_b = 0.01 * jax.random.normal(ks[9], (N_RG_LAYERS, RG_WIDTH), f32)
    rg_w_a = jax.random.normal(ks[10], (N_RG_LAYERS, RG_BLOCKS, RG_BLOCK_DIM, RG_BLOCK_DIM), f32) * RG_BLOCK_DIM ** -0.5
    rg_b_a = 0.01 * jax.random.normal(ks[11], (N_RG_LAYERS, RG_WIDTH), f32)
    rg_w_x = jax.random.normal(ks[12], (N_RG_LAYERS, RG_BLOCKS, RG_BLOCK_DIM, RG_BLOCK_DIM), f32) * RG_BLOCK_DIM ** -0.5
    rg_b_x = 0.01 * jax.random.normal(ks[13], (N_RG_LAYERS, RG_WIDTH), f32)
    u = jax.random.uniform(ks[14], (N_RG_LAYERS, RG_WIDTH), f32, 0.9, 0.999)
    s = u ** (1.0 / RG_C)
    rg_lambda = jnp.log(s) - jnp.log1p(-s)
    rg_w_o = jax.random.normal(ks[15], (N_RG_LAYERS, RG_WIDTH, D_MODEL), f32) * (RG_WIDTH ** -0.5 * res_scale)
    norm_final = 1.0 + 0.02 * jax.random.normal(ks[16], (D_MODEL,), f32)
    return {'x': x, 'norm_mix': norm_mix, 'norm_mlp': norm_mlp, 'mlp_w1': mlp_w1, 'mlp_w2': mlp_w2,
            'sb_w_qkv': sb_w_qkv, 'sb_w_o': sb_w_o, 'rg_w_in': rg_w_in, 'rg_conv_w': rg_conv_w,
            'rg_conv_b': rg_conv_b, 'rg_w_a': rg_w_a, 'rg_b_a': rg_b_a, 'rg_w_x': rg_w_x,
            'rg_b_x': rg_b_x, 'rg_lambda': rg_lambda, 'rg_w_o': rg_w_o, 'norm_final': norm_final}


def reference(x, norm_mix, norm_mlp, mlp_w1, mlp_w2, sb_w_qkv, sb_w_o, rg_w_in, rg_conv_w,
              rg_conv_b, rg_w_a, rg_b_a, rg_w_x, rg_b_x, rg_lambda, rg_w_o, norm_final):
    ia = 0
    ib = 0
    for layer in range(DEPTH):
        h = rms_norm(x, norm_mix[layer])
        if layer % N_MIXERS == 0:
            y = stick_breaking_attention(h, sb_w_qkv[ia], sb_w_o[ia])
            ia += 1
        else:
            y = rglru_block(h, rg_w_in[ib], rg_conv_w[ib], rg_conv_b[ib], rg_w_a[ib], rg_b_a[ib],
                            rg_w_x[ib], rg_b_x[ib], rg_lambda[ib], rg_w_o[ib])
            ib += 1
        x = x + y
        h = rms_norm(x, norm_mlp[layer])
        x = x + squared_relu_mlp(h, mlp_w1[layer], mlp_w2[layer])
    return rms_norm(x, norm_final)
```

```cpp
#include <hip/hip_runtime.h>
#include <cstdio>
#include <cstdint>
#include <cmath>
namespace pg8 {
#define PG8_LAS __attribute__((address_space(3)))
typedef unsigned short bf16_t;
typedef short bf16x8 __attribute__((ext_vector_type(8)));
typedef float f32x4 __attribute__((ext_vector_type(4)));
typedef unsigned u32x4 __attribute__((ext_vector_type(4)));
constexpr int BM = 256, BK = 64, HALF = 128, HTB = HALF * BK * 2  , STAGE_BYTES = 8 * HTB, NXCD = 8, WGM = 8;

__host__ __device__ __forceinline__ int lds_byte(int r, int c) { const int st = (r >> 4) * 2 + (c >> 5), rr = r & 15, cc = c & 31, ob = rr * 64 + cc * 2; return st * 1024 + (ob ^ (((ob >> 9) & 1) << 5)); }
__host__ __device__ __forceinline__ void stage_rc(int b, int& R, int& C) { const int st = b / 1024, sb = b % 1024, swz = sb ^ (((sb >> 9) & 1) << 5); R = (st >> 1) * 16 + swz / 64; C = (st & 1) * 32 + (swz % 64) / 2; }
__host__ __device__ __forceinline__ int perm32(int rho) { const int n = rho >> 4, i = rho & 15; return 8 * (i >> 2) + 4 * n + (i & 3); }

struct Unit { int pm, pn; };
struct Gemm { const bf16_t* A; const bf16_t* Bt; int M, N, K; };

struct StaticOrder {
    int nM, nN, nwg, G, c;
    __host__ __device__ void init(int M, int N, int G_, int c_) { nM = M / BM; nN = N / BM; nwg = nM * nN; G = G_; c = c_; }
    __host__ __device__ bool next(int i, Unit& u) const {
        const long L = (long)i * G + c; if (L >= nwg) return false;
        int wgid = (int)L; { const int q = nwg / NXCD, r = nwg % NXCD, xcd = wgid % NXCD, off = wgid / NXCD; wgid = (xcd < r ? xcd * (q + 1) : r * (q + 1) + (xcd - r) * q) + off; }
        const int nig = WGM * nN, gid = wgid / nig, fm = gid * WGM, gsz = (nM - fm) < WGM ? (nM - fm) : WGM;
        u.pm = fm + ((wgid % nig) % gsz); u.pn = (wgid % nig) / gsz; return true;
    }
    __device__ __forceinline__ void a_ready(const Unit&) const {}
    __device__ __forceinline__ void done(const Unit&) const {}
};

__device__ __forceinline__ unsigned cvt_pk_bf16(float lo, float hi) { unsigned r; asm volatile("v_cvt_pk_bf16_f32 %0, %1, %2" : "=v"(r) : "v"(lo), "v"(hi)); return r; }
typedef unsigned u32x4 __attribute__((ext_vector_type(4)));
constexpr float RMS_EPS = 1e-6f;
constexpr float QSCALE = 0.125f * 1.4426950408889634f;
__device__ __forceinline__ float row_rstd(const float* ssq, int row) {
    const f32x4* sp = (const f32x4*)(ssq + (size_t)row * 16);
    const f32x4 a = sp[0], b = sp[1], c = sp[2], d = sp[3];
    const f32x4 s = (a + b) + (c + d);
    return __builtin_amdgcn_rsqf(((s.x + s.y) + (s.z + s.w)) * (1.0f / 1024.0f) + RMS_EPS);
}
__device__ __forceinline__ float gelu_tanh(float x) {
    const float u = x * (1.0f + 0.044715f * x * x) * (2.0f * 0.7978845608028654f * 1.4426950408889634f);
    const float e = __builtin_amdgcn_exp2f(-fminf(fmaxf(u, -100.f), 100.f));
    return x * __builtin_amdgcn_rcpf(1.0f + e);
}
struct EpiAct {
    static constexpr bool PERM = true, AFTER_DRAIN = false;
    bf16_t* O; int ldc; int split_cols; size_t split_stride; const PG8_LAS float* rtab; int MODE;
    __device__ __forceinline__ void operator()(const f32x4 (&acc)[2][2][4][2], const Unit& u, int wr, int wc, int fr, int fq) const {
        { int t2 = threadIdx.x; asm volatile("" : "+v"(t2)); fr = t2 & 15; fq = (t2 >> 4) & 3; }
        const int row0 = u.pm * BM + wr * 64 + fr; int colt = u.pn * BM; bf16_t* base = O; int t = 0;
        if (split_cols) { t = colt >> 10; base += (size_t)t * split_stride; colt &= 1023; }
        const int col0 = colt + wc * 32 + 8 * fq;
#pragma unroll
        for (int ai = 0; ai < 2; ++ai)
#pragma unroll
            for (int m = 0; m < 4; ++m) {
                const int row = row0 + ai * HALF + m * 16;
                float rs = rtab[((u.pm >> 3) & 1) * 256 + (row & 255)];
                if (MODE == 0 && t == 0) rs *= QSCALE;
                bf16_t* rowp = base + (size_t)row * ldc + col0;
#pragma unroll
                for (int bj = 0; bj < 2; ++bj) {
                    f32x4 v0 = acc[ai][bj][m][0] * rs, v1 = acc[ai][bj][m][1] * rs;
                    if (MODE == 1) { if (t == 0) {
#pragma unroll
                        for (int e = 0; e < 4; ++e) { v0[e] = gelu_tanh(v0[e]); v1[e] = gelu_tanh(v1[e]); } } }
                    if (MODE == 2) {
#pragma unroll
                        for (int e = 0; e < 4; ++e) { const float a = fmaxf(v0[e], 0.f), b = fmaxf(v1[e], 0.f); v0[e] = a * a; v1[e] = b * b; } }
                    u32x4 w; w.x = cvt_pk_bf16(v0[0], v0[1]); w.y = cvt_pk_bf16(v0[2], v0[3]); w.z = cvt_pk_bf16(v1[0], v1[1]); w.w = cvt_pk_bf16(v1[2], v1[3]);
                    *(u32x4*)(rowp + bj * HALF) = w;
                }
            }
    }
};
struct EpiRes {
    static constexpr bool PERM = true, AFTER_DRAIN = false;
    unsigned char* wsb; size_t xb_off, ssq_off;
    __device__ __forceinline__ void operator()(const f32x4 (&acc)[2][2][4][2], const Unit& u, int wr, int wc, int fr, int fq) const {
        { int t2 = threadIdx.x; asm volatile("" : "+v"(t2)); fr = t2 & 15; fq = (t2 >> 4) & 3; }
        bf16_t* xb = (bf16_t*)(wsb + xb_off); float* ssq = (float*)(wsb + ssq_off);
        const int row0 = u.pm * BM + wr * 64 + fr; const int col0 = u.pn * BM + wc * 32 + 8 * fq;
        u32x4 pre[2][4][2];
#pragma unroll
        for (int ai = 0; ai < 2; ++ai)
#pragma unroll
            for (int m = 0; m < 4; ++m)
#pragma unroll
                for (int bj = 0; bj < 2; ++bj) pre[ai][m][bj] = *(const u32x4*)(xb + (size_t)(row0 + ai * HALF + m * 16) * 1024 + col0 + bj * HALF);
#pragma unroll
        for (int ai = 0; ai < 2; ++ai)
#pragma unroll
            for (int m = 0; m < 4; ++m) {
                const int row = row0 + ai * HALF + m * 16; float q = 0.f;
#pragma unroll
                for (int bj = 0; bj < 2; ++bj) {
                    const u32x4 b = pre[ai][m][bj];
                    f32x4 v0 = acc[ai][bj][m][0], v1 = acc[ai][bj][m][1];
                    v0[0] += __builtin_bit_cast(float, b.x << 16); v0[1] += __builtin_bit_cast(float, b.x & 0xffff0000u); v0[2] += __builtin_bit_cast(float, b.y << 16); v0[3] += __builtin_bit_cast(float, b.y & 0xffff0000u);
                    v1[0] += __builtin_bit_cast(float, b.z << 16); v1[1] += __builtin_bit_cast(float, b.z & 0xffff0000u); v1[2] += __builtin_bit_cast(float, b.w << 16); v1[3] += __builtin_bit_cast(float, b.w & 0xffff0000u);
                    q += (v0[0] * v0[0] + v0[1] * v0[1]) + (v0[2] * v0[2] + v0[3] * v0[3]) + (v1[0] * v1[0] + v1[1] * v1[1]) + (v1[2] * v1[2] + v1[3] * v1[3]);
                    u32x4 w; w.x = cvt_pk_bf16(v0[0], v0[1]); w.y = cvt_pk_bf16(v0[2], v0[3]); w.z = cvt_pk_bf16(v1[0], v1[1]); w.w = cvt_pk_bf16(v1[2], v1[3]);
                    *(u32x4*)(xb + (size_t)row * 1024 + col0 + bj * HALF) = w;
                }
                q += __shfl_xor(q, 16); q += __shfl_xor(q, 32);
                if (fq == 0) ssq[(size_t)row * 16 + u.pn * 4 + wc] = q;
            }
    }
};
template <class Sched> __device__ __forceinline__ void fill_rstd(PG8_LAS float* rtab, const float* ssq, const Sched& S) {
    int last0 = -1, last1 = -1; Unit u; int tx = threadIdx.x; asm volatile("" : "+v"(tx));
    for (int i = 0; S.next(i, u); ++i) {
        const int slot = (u.pm >> 3) & 1; const int last = slot ? last1 : last0;
        if (last != u.pm) { if (tx < 256) rtab[slot * 256 + tx] = row_rstd(ssq, u.pm * BM + tx); if (slot) last1 = u.pm; else last0 = u.pm; }
    }
    __syncthreads();
}

struct FastOrder {
    int nq, sh, nwg, q, G, c;
    __device__ __forceinline__ void init(int M_, int N_, int G_, int c_) { const int nN = N_ / BM; nq = nN >> 2; sh = nq >> 1; nwg = (M_ / BM) * nN; q = nwg >> 3; G = G_; c = c_; }
    __device__ __forceinline__ bool next(int i, Unit& u) const {
        const int L = i * G + c; if (L >= nwg) return false;
        const int wgid = (L & 7) * q + (L >> 3);
        const int y = wgid >> 5;
        const int gid = (nq == 3) ? ((y * 43691) >> 17) : (y >> sh);
        const int rem = wgid - gid * (nq << 5);
        u.pm = gid * 8 + (rem & 7); u.pn = rem >> 3; return true;
    }
    __device__ __forceinline__ void a_ready(const Unit&) const {}
    __device__ __forceinline__ void done(const Unit&) const {}
};
template <class Epi, class Sched, bool ALIGN_EPI = false, bool SP2 = false>
__device__ __forceinline__ void gemm_phase(PG8_LAS unsigned char* lds, const Gemm g, const Sched& S, const Epi& E) {
    int tid_ = threadIdx.x; asm volatile("" : "+v"(tid_));
    const int tid = tid_, wid = __builtin_amdgcn_readfirstlane(tid >> 6), lane = tid & 63, wr = wid >> 2, wc = wid & 3, fr = lane & 15, fq = lane >> 4;
    const int K = g.K, nt = K / BK;
    unsigned voffA, voffB;
    { int R, C; stage_rc(tid * 16, R, C); const int Rb = Epi::PERM ? ((R & ~31) + perm32(R & 31)) : R;
        voffA = (unsigned)(R * K + C) * 2u; voffB = (unsigned)(Rb * K + C) * 2u; }
    const size_t qstep = (size_t)64 * K * 2;
    const size_t kstep = (size_t)(BK * 2);
    const size_t hstep = (size_t)HALF * K * 2;
    const size_t tstep = 2 * hstep;
    const unsigned ldsw = (unsigned)wid * 1024u;
    const int aoff = lds_byte(wr * 64 + fr, fq * 8), boff = lds_byte(wc * 32 + fr, fq * 8);
#define PG8_SA(b, h) (((b) * 2 + (h)) * HTB)
#define PG8_SB(b, h) ((4 + (b) * 2 + (h)) * HTB)
#define PG8_STAGE(bufoff, gbase, voff) do { _Pragma("unroll") for (int _i = 0; _i < 2; ++_i) \
        __builtin_amdgcn_global_load_lds((const unsigned*)((const char*)(gbase) + _i * qstep + (voff)), (PG8_LAS unsigned*)(lds + (bufoff) + ldsw + _i * 8192), 16, 0, 0); } while (0)
#define PG8_LDA(dst, b, h) do { _Pragma("unroll") for (int m = 0; m < 4; ++m) _Pragma("unroll") for (int k = 0; k < 2; ++k) dst[m][k] = *(const PG8_LAS bf16x8*)(lds + PG8_SA(b, h) + aoff + m * 2048 + k * 1024); } while (0)
#define PG8_LDB(dst, b, h) do { _Pragma("unroll") for (int n = 0; n < 2; ++n) _Pragma("unroll") for (int k = 0; k < 2; ++k) dst[n][k] = *(const PG8_LAS bf16x8*)(lds + PG8_SB(b, h) + boff + n * 2048 + k * 1024); } while (0)
#define PG8_MMA(ai, bj, At, Bt) do { __builtin_amdgcn_s_setprio(1); _Pragma("unroll") for (int m = 0; m < 4; ++m) _Pragma("unroll") for (int n = 0; n < 2; ++n) _Pragma("unroll") for (int k = 0; k < 2; ++k) \
        acc[ai][bj][m][n] = __builtin_amdgcn_mfma_f32_16x16x32_bf16(Bt[n][k], At[m][k], acc[ai][bj][m][n], 0, 0, 0); __builtin_amdgcn_s_setprio(0); } while (0)
#define PG8_WAIT_V(n) asm volatile("s_waitcnt vmcnt(" #n ")" ::: "memory")
#define PG8_WAIT_L(n) asm volatile("s_waitcnt lgkmcnt(" #n ")" ::: "memory")
#define PG8_BAR __builtin_amdgcn_s_barrier()
#define PG8_SCHED __builtin_amdgcn_sched_barrier(0)
    Unit cur, nxt; int ui = 0;
    if (!S.next(0, cur)) return;
    f32x4 acc[2][2][4][2];
#pragma unroll
    for (int a = 0; a < 2; ++a)
#pragma unroll
        for (int b = 0; b < 2; ++b)
#pragma unroll
            for (int m = 0; m < 4; ++m)
#pragma unroll
                for (int n = 0; n < 2; ++n) acc[a][b][m][n] = (f32x4){0.f, 0.f, 0.f, 0.f};
    bf16x8 At[4][2], B0[2][2], B1[2][2];
    const char* cA = (const char*)g.A + (size_t)cur.pm * tstep; const char* cB = (const char*)g.Bt + (size_t)cur.pn * tstep;
    S.a_ready(cur);
    if constexpr (SP2) {
        PG8_STAGE(PG8_SB(0, 0), cB, voffB); PG8_STAGE(PG8_SB(0, 1), cB + hstep, voffB); PG8_STAGE(PG8_SA(0, 0), cA, voffA); PG8_STAGE(PG8_SA(0, 1), cA + hstep, voffA);
        if (wr == 1) PG8_BAR;
        PG8_WAIT_V(2); PG8_BAR;
        PG8_STAGE(PG8_SB(1, 0), cB + kstep, voffB); PG8_STAGE(PG8_SA(1, 0), cA + kstep, voffA); PG8_STAGE(PG8_SB(1, 1), cB + hstep + kstep, voffB);
        PG8_WAIT_V(6); PG8_BAR;
    } else {
        PG8_STAGE(PG8_SB(0, 0), cB, voffB); PG8_STAGE(PG8_SA(0, 0), cA, voffA); PG8_STAGE(PG8_SB(0, 1), cB + hstep, voffB); PG8_STAGE(PG8_SA(0, 1), cA + hstep, voffA);
        if (wr == 1) PG8_BAR;
        PG8_WAIT_V(4); PG8_BAR;
        PG8_STAGE(PG8_SB(1, 0), cB + kstep, voffB); PG8_STAGE(PG8_SA(1, 0), cA + kstep, voffA); PG8_STAGE(PG8_SB(1, 1), cB + hstep + kstep, voffB);
        PG8_WAIT_V(6); PG8_BAR;
    }
    for (;;) {
        const bool has_next = S.next(ui + 1, nxt);
        const char* nA = has_next ? (const char*)g.A + (size_t)nxt.pm * tstep : cA; const char* nB = has_next ? (const char*)g.Bt + (size_t)nxt.pn * tstep : cB;
        for (int t = 0; t < nt; t += 2) {
            const bool last = (t == nt - 2);
            const char* a1 = cA + (size_t)(t + 1) * kstep;
            const char* a2 = last ? nA : cA + (size_t)(t + 2) * kstep; const char* b2 = last ? nB : cB + (size_t)(t + 2) * kstep;
            const char* a3 = a2 + kstep; const char* b3 = b2 + kstep;
            if (last && has_next) S.a_ready(nxt);
            if constexpr (SP2) {
            PG8_LDB(B0, 0, 0); PG8_LDB(B1, 0, 1); PG8_SCHED; PG8_LDA(At, 0, 0); PG8_STAGE(PG8_SA(1, 1), a1 + hstep, voffA);
            PG8_WAIT_V(8); PG8_WAIT_L(0); PG8_BAR; PG8_MMA(0, 0, At, B0); PG8_MMA(0, 1, At, B1); PG8_BAR; PG8_SCHED;
            PG8_LDA(At, 0, 1); PG8_STAGE(PG8_SB(0, 0), b2, voffB); PG8_STAGE(PG8_SB(0, 1), b2 + hstep, voffB); PG8_STAGE(PG8_SA(0, 0), a2, voffA);
            PG8_WAIT_V(8); PG8_WAIT_L(0); PG8_BAR; PG8_MMA(1, 0, At, B0); PG8_MMA(1, 1, At, B1); PG8_BAR; PG8_SCHED;
            PG8_LDB(B0, 1, 0); PG8_LDB(B1, 1, 1); PG8_SCHED; PG8_LDA(At, 1, 0); PG8_STAGE(PG8_SA(0, 1), a2 + hstep, voffA);
            PG8_WAIT_V(8); PG8_WAIT_L(0); PG8_BAR; PG8_MMA(0, 0, At, B0); PG8_MMA(0, 1, At, B1); PG8_BAR; PG8_SCHED;
            PG8_LDA(At, 1, 1); PG8_STAGE(PG8_SB(1, 0), b3, voffB); PG8_STAGE(PG8_SB(1, 1), b3 + hstep, voffB); PG8_STAGE(PG8_SA(1, 0), a3, voffA);
            PG8_WAIT_V(8); PG8_WAIT_L(0); PG8_BAR; PG8_MMA(1, 0, At, B0); PG8_MMA(1, 1, At, B1); PG8_BAR; PG8_SCHED;
            } else {
            PG8_LDB(B0, 0, 0); PG8_SCHED; PG8_LDA(At, 0, 0); PG8_STAGE(PG8_SA(1, 1), a1 + hstep, voffA);
            PG8_WAIT_L(8); PG8_BAR; PG8_WAIT_L(0); PG8_MMA(0, 0, At, B0); PG8_BAR; PG8_SCHED;
            PG8_LDB(B1, 0, 1); PG8_STAGE(PG8_SB(0, 0), b2, voffB);
            PG8_BAR; PG8_WAIT_L(0); PG8_MMA(0, 1, At, B1); PG8_BAR;
            PG8_LDA(At, 0, 1); PG8_STAGE(PG8_SA(0, 0), a2, voffA);
            PG8_BAR; PG8_WAIT_L(0); PG8_MMA(1, 0, At, B0); PG8_BAR; PG8_SCHED;
            PG8_STAGE(PG8_SB(0, 1), b2 + hstep, voffB);
            PG8_WAIT_V(6); PG8_BAR; PG8_MMA(1, 1, At, B1); PG8_BAR;
            PG8_LDB(B0, 1, 0); PG8_SCHED; PG8_LDA(At, 1, 0); PG8_STAGE(PG8_SA(0, 1), a2 + hstep, voffA);
            PG8_WAIT_L(8); PG8_BAR; PG8_WAIT_L(0); PG8_MMA(0, 0, At, B0); PG8_BAR; PG8_SCHED;
            PG8_LDB(B1, 1, 1); PG8_STAGE(PG8_SB(1, 0), b3, voffB);
            PG8_BAR; PG8_WAIT_L(0); PG8_MMA(0, 1, At, B1); PG8_BAR;
            PG8_LDA(At, 1, 1); PG8_STAGE(PG8_SA(1, 0), a3, voffA);
            PG8_BAR; PG8_WAIT_L(0); PG8_MMA(1, 0, At, B0); PG8_BAR; PG8_SCHED;
            PG8_STAGE(PG8_SB(1, 1), b3 + hstep, voffB);
            PG8_WAIT_V(6); PG8_BAR; PG8_MMA(1, 1, At, B1); PG8_BAR;
            }
        }
        if constexpr (ALIGN_EPI) { if (wr == 0) PG8_BAR; }
        if constexpr (!Epi::AFTER_DRAIN) { E(acc, cur, wr, wc, fr, fq); S.done(cur); }
        if (!has_next) break;
#pragma unroll
        for (int a = 0; a < 2; ++a)
#pragma unroll
            for (int b = 0; b < 2; ++b)
#pragma unroll
                for (int m = 0; m < 4; ++m)
#pragma unroll
                    for (int n = 0; n < 2; ++n) acc[a][b][m][n] = (f32x4){0.f, 0.f, 0.f, 0.f};
        cur = nxt; cA = nA; cB = nB; ++ui;
        if constexpr (ALIGN_EPI) { if (wr == 1) PG8_BAR; }
    }
    PG8_WAIT_V(0);
    if constexpr (!ALIGN_EPI) { if (wr == 0) PG8_BAR; }
    PG8_BAR;
    if constexpr (Epi::AFTER_DRAIN) { E.fused(acc, cur, wr, wc, fr, fq, lds, wid, lane); S.done(cur); }
#undef PG8_SA
#undef PG8_SB
#undef PG8_STAGE
#undef PG8_LDA
#undef PG8_LDB
#undef PG8_MMA
#undef PG8_WAIT_V
#undef PG8_WAIT_L
#undef PG8_BAR
#undef PG8_SCHED
}
}
#define LAS __attribute__((address_space(3)))
#define XB_TMO      128
#define XB_XCNT(j)  (256  + 64 * (j))
#define XB_XSUB(j)  (1280 + 64 * (j))
#define XB_XGEN(j)  (2304 + 64 * (j))
#define XB_TOP      3328
#define XB_TOPGEN   3392
#define XCD_BAR_WORDS 3456
#define XB_SPIN_CAP (1u << 22)

__device__ __forceinline__ unsigned xb_ld(unsigned* p)              { return __hip_atomic_load(p, __ATOMIC_RELAXED, __HIP_MEMORY_SCOPE_AGENT); }
__device__ __forceinline__ unsigned xb_add(unsigned* p, unsigned v) { return __hip_atomic_fetch_add(p, v, __ATOMIC_RELAXED, __HIP_MEMORY_SCOPE_AGENT); }
__device__ __forceinline__ unsigned xb_xcc_id() { return (unsigned)__builtin_amdgcn_s_getreg((3 << 11) | 20) & 0xFu; }
#define XB_SPIN(cond, bar) do { unsigned _sp = 0; while (cond) { __builtin_amdgcn_s_sleep(1); \
    if ((++_sp & 255u) == 0u) { if (xb_ld(&(bar)[XB_TMO])) break; if (_sp > XB_SPIN_CAP) { atomicAdd(&(bar)[XB_TMO], 1u); break; } } } } while (0)

struct XcdBarrier {
    unsigned* bar; unsigned x;
    volatile LAS unsigned* st;
};

__device__ __forceinline__ XcdBarrier xcd_barrier_post(unsigned* bar, volatile LAS unsigned* st) {
    XcdBarrier b; b.bar = bar; b.x = xb_xcc_id(); b.st = st;
    if (threadIdx.x == 0) (void)xb_add(&bar[XB_XCNT(b.x)], 1u);
    return b;
}
__device__ __forceinline__ void xcd_barrier_complete(unsigned* bar, unsigned x, unsigned& nloc, unsigned& nx) {
    const unsigned G = gridDim.x * gridDim.y * gridDim.z;
    unsigned sum, cnt, mine, sp = 0u;
    for (;;) {
        sum = 0u; cnt = 0u; mine = 0u;
#pragma unroll
        for (unsigned j = 0; j < 16; ++j) { const unsigned c = xb_ld(&bar[XB_XCNT(j)]); sum += c; cnt += (c > 0u) ? 1u : 0u; mine = (j == x) ? c : mine; }
        if (sum == G) break;
        __builtin_amdgcn_s_sleep(1);
        if ((++sp & 255u) == 0u) { if (xb_ld(&bar[XB_TMO])) break; if (sp > XB_SPIN_CAP) { atomicAdd(&bar[XB_TMO], 1u); break; } }
    }
    nloc = mine > 0u ? mine : 1u; nx = cnt > 0u ? cnt : 1u;
}

__device__ __forceinline__ void xcd_barrier(const XcdBarrier& b) {
    asm volatile("s_waitcnt vmcnt(0)" ::: "memory");
    __syncthreads();
    if (threadIdx.x == 0) {
        unsigned* bar = b.bar;
        __builtin_amdgcn_s_waitcnt(0);
        unsigned nloc = b.st[0], nx = b.st[1];
        if (nloc == 0u) { xcd_barrier_complete(bar, b.x, nloc, nx); b.st[0] = nloc; b.st[1] = nx; }
        const unsigned old = xb_add(&bar[XB_XSUB(b.x)], 1u);
        const unsigned gen = old / nloc;
        if (old + 1u == (gen + 1u) * nloc) {
            __builtin_amdgcn_fence(__ATOMIC_RELEASE, "agent");
            asm volatile("s_waitcnt vmcnt(0)" ::: "memory");
            const unsigned og = xb_add(&bar[XB_TOP], 1u);
            const unsigned tg = og / nx;
            if (og + 1u == (tg + 1u) * nx) xb_add(&bar[XB_TOPGEN], 1u);
            else XB_SPIN(xb_ld(&bar[XB_TOPGEN]) == tg, bar);
            __builtin_amdgcn_fence(__ATOMIC_ACQUIRE, "agent");
            xb_add(&bar[XB_XGEN(b.x)], 1u);
            asm volatile("s_waitcnt vmcnt(0)" ::: "memory");
        } else {
            XB_SPIN(xb_ld(&bar[XB_XGEN(b.x)]) == gen, bar);
            __builtin_amdgcn_fence(__ATOMIC_ACQUIRE, "agent");
            asm volatile("s_waitcnt vmcnt(0)" ::: "memory");
        }
    }
    __syncthreads();
}

#include <hip/hip_cooperative_groups.h>
namespace cg = cooperative_groups;
typedef pg8::bf16_t bf16_t;
typedef pg8::bf16x8 bf16x8;
typedef pg8::f32x4 f32x4;
typedef pg8::u32x4 u32x4;
typedef float f32x16 __attribute__((ext_vector_type(16)));
typedef float f32x2 __attribute__((ext_vector_type(2)));
typedef unsigned u32x2 __attribute__((ext_vector_type(2)));
typedef short v4i16_t __attribute__((ext_vector_type(4)));

constexpr int BATCH = 16, SEQ = 2048, DM = 1024, M = BATCH * SEQ, DEPTH = 4, FF = 4096, NHEAD = 16;
constexpr int NWAVES = 8;
#ifndef MK_ONE_LAUNCH
#define MK_ONE_LAUNCH 1
#endif
constexpr size_t MiB = 1u << 20;
constexpr size_t WS_SSQ = 1 * MiB;
constexpr size_t WS_W1 = 4 * MiB, WS_W2 = 36 * MiB, WS_WQKV = 68 * MiB, WS_WO = 80 * MiB, WS_WIN = 84 * MiB, WS_WRO = 92 * MiB;
constexpr size_t WS_XB = 96 * MiB;
constexpr size_t WS_BIG = 160 * MiB;
constexpr size_t WS_END = 416 * MiB;
constexpr int LDS_BYTES = 147456;
constexpr int NPHASE = 1 + 5 * DEPTH + 1;

__device__ __forceinline__ unsigned f2bf(float f) { unsigned u = __builtin_bit_cast(unsigned, f); return (u + 0x7fffu + ((u >> 16) & 1u)) >> 16; }
__device__ __forceinline__ unsigned pk2(float lo, float hi) { return f2bf(lo) | (f2bf(hi) << 16); }
__device__ __forceinline__ float bf_lo(unsigned w) { return __builtin_bit_cast(float, w << 16); }
__device__ __forceinline__ float bf_hi(unsigned w) { return __builtin_bit_cast(float, w & 0xffff0000u); }
__device__ __forceinline__ float wave_sum(float v) {
#pragma unroll
    for (int o = 1; o < 64; o <<= 1) v += __shfl_xor(v, o);
    return v;
}

__device__ __forceinline__ void p0_transpose_item(const float* W, int K, int N, bf16_t* WT, const float* gain, LAS float* scr, int item, int lane) {
    const int nblk = N / 32, kb = item / nblk, nb = item % nblk, k0 = 64 * kb, n0 = 32 * nb;
    float wv[32];
#pragma unroll
    for (int i = 0; i < 32; ++i) { const int kk = 2 * i + (lane >> 5); wv[i] = W[(size_t)(k0 + kk) * N + n0 + (lane & 31)]; }
#pragma unroll
    for (int i = 0; i < 32; ++i) { const int kk = 2 * i + (lane >> 5); const float g = gain ? gain[k0 + kk] : 1.0f; scr[kk * 33 + (lane & 31)] = wv[i] * g; }
    asm volatile("s_waitcnt lgkmcnt(0)" ::: "memory");
    const int c = lane & 7;
#pragma unroll
    for (int j = 0; j < 4; ++j) { const int n = (lane >> 3) + 8 * j; const LAS float* s = scr + (8 * c) * 33 + n;
        u32x4 o; o.x = pk2(s[0 * 33], s[1 * 33]); o.y = pk2(s[2 * 33], s[3 * 33]); o.z = pk2(s[4 * 33], s[5 * 33]); o.w = pk2(s[6 * 33], s[7 * 33]);
        *(u32x4*)(WT + (size_t)(n0 + n) * K + k0 + 8 * c) = o; }
    asm volatile("s_waitcnt lgkmcnt(0)" ::: "memory");
}

struct Args { const float* in[17]; float* out; unsigned char* ws; int ph_lo, ph_hi; };
typedef const __attribute__((address_space(4))) Args* ArgsP;
__device__ __forceinline__ ArgsP kargs() {
    const unsigned long long p = (unsigned long long)__builtin_amdgcn_kernarg_segment_ptr();
    unsigned lo = (unsigned)p, hi = (unsigned)(p >> 32);
    asm volatile("" : "+s"(lo), "+s"(hi));
    lo = __builtin_amdgcn_readfirstlane(lo); hi = __builtin_amdgcn_readfirstlane(hi);
    return (ArgsP)(((unsigned long long)hi << 32) | lo);
}
#define KA (kargs())
#define PHASE_IDS() int tid_ = threadIdx.x; asm volatile("" : "+v"(tid_)); const int tid = tid_, lane = tid & 63, wave = __builtin_amdgcn_readfirstlane(tid >> 6); \
    int bx_ = blockIdx.x; asm volatile("" : "+s"(bx_)); bx_ = __builtin_amdgcn_readfirstlane(bx_); int Gn_ = gridDim.x; asm volatile("" : "+s"(Gn_)); Gn_ = __builtin_amdgcn_readfirstlane(Gn_); const int vcu_ = (Gn_ % 8 == 0) ? (bx_ % 8) * (Gn_ / 8) + bx_ / 8 : bx_; const int gw = vcu_ * NWAVES + wave, ngw = Gn_ * NWAVES; (void)tid; (void)lane; (void)gw; (void)ngw

__device__ __forceinline__ void p0_prologue(LAS unsigned char* lds) {
    PHASE_IDS();
    LAS float* scr = (LAS float*)(lds + wave * 16384);
    ArgsP ap = KA; unsigned char* ws = ap->ws;
    constexpr int I_W1 = 16 * 128, I_W2 = 64 * 32, I_QKV = 16 * 96, I_WO = 16 * 32, I_WIN = 16 * 64;
    constexpr int NITEMS = 4 * I_W1 + 4 * I_W2 + 2 * I_QKV + 2 * I_WO + 2 * I_WIN + 2 * I_WO;
    for (int it = gw; it < NITEMS; it += ngw) {
        int r = it;
        if (r < 4 * I_W1) { const int l = r / I_W1; p0_transpose_item(ap->in[3] + (size_t)l * DM * FF, DM, FF, (bf16_t*)(ws + WS_W1) + (size_t)l * DM * FF, ap->in[2] + l * DM, scr, r % I_W1, lane); continue; } r -= 4 * I_W1;
        if (r < 4 * I_W2) { const int l = r / I_W2; p0_transpose_item(ap->in[4] + (size_t)l * DM * FF, FF, DM, (bf16_t*)(ws + WS_W2) + (size_t)l * DM * FF, nullptr, scr, r % I_W2, lane); continue; } r -= 4 * I_W2;
        if (r < 2 * I_QKV) { const int l = r / I_QKV; p0_transpose_item(ap->in[5] + (size_t)l * DM * 3 * DM, DM, 3 * DM, (bf16_t*)(ws + WS_WQKV) + (size_t)l * DM * 3 * DM, ap->in[1] + (2 * l) * DM, scr, r % I_QKV, lane); continue; } r -= 2 * I_QKV;
        if (r < 2 * I_WO) { const int l = r / I_WO; p0_transpose_item(ap->in[6] + (size_t)l * DM * DM, DM, DM, (bf16_t*)(ws + WS_WO) + (size_t)l * DM * DM, nullptr, scr, r % I_WO, lane); continue; } r -= 2 * I_WO;
        if (r < 2 * I_WIN) { const int l = r / I_WIN; p0_transpose_item(ap->in[7] + (size_t)l * DM * 2 * DM, DM, 2 * DM, (bf16_t*)(ws + WS_WIN) + (size_t)l * DM * 2 * DM, ap->in[1] + (2 * l + 1) * DM, scr, r % I_WIN, lane); continue; } r -= 2 * I_WIN;
        { const int l = r / I_WO; p0_transpose_item(ap->in[15] + (size_t)l * DM * DM, DM, DM, (bf16_t*)(ws + WS_WRO) + (size_t)l * DM * DM, nullptr, scr, r % I_WO, lane); }
    }
    const float* x = ap->in[0]; bf16_t* xb = (bf16_t*)(ws + WS_XB); float* ssq = (float*)(ws + WS_SSQ);
    for (int m0 = gw * 4; m0 < M; m0 += ngw * 4) {
        f32x4 v[4][4];
#pragma unroll
        for (int r = 0; r < 4; ++r)
#pragma unroll
            for (int j = 0; j < 4; ++j) v[r][j] = ((const f32x4*)(x + (size_t)(m0 + r) * DM) + lane)[64 * j];
#pragma unroll
        for (int r = 0; r < 4; ++r) {
            u32x2* o8 = (u32x2*)(xb + (size_t)(m0 + r) * DM) + lane; float s = 0.f;
#pragma unroll
            for (int j = 0; j < 4; ++j) { const f32x4 t = v[r][j]; s += (t.x * t.x + t.y * t.y) + (t.z * t.z + t.w * t.w); u32x2 w; w.x = pk2(t.x, t.y); w.y = pk2(t.z, t.w); o8[64 * j] = w; }
            s = wave_sum(s);
            if (lane < 16) ssq[(size_t)(m0 + r) * 16 + lane] = (lane == 0) ? s : 0.f;
        }
    }
}

__device__ __forceinline__ void final_norm(float* out, const bf16_t* xb, const float* ssq, const float* g) {
    PHASE_IDS();
    for (int m = gw; m < M; m += ngw) {
        const float rs = pg8::row_rstd(ssq, m);
        const u32x2* xr = (const u32x2*)(xb + (size_t)m * DM) + lane; f32x4* orow = (f32x4*)(out + (size_t)m * DM) + lane; const f32x4* gr = (const f32x4*)g + lane;
#pragma unroll
        for (int j = 0; j < 4; ++j) { const u32x2 w = xr[64 * j]; const f32x4 gg = gr[64 * j]; f32x4 v = {bf_lo(w.x), bf_hi(w.x), bf_lo(w.y), bf_hi(w.y)}; orow[64 * j] = v * rs * gg; }
    }
}

__device__ __forceinline__ int crow(int r, int hi) { return (r & 3) + 8 * (r >> 2) + 4 * hi; }
constexpr int VPITCH = 144;
template <bool DIAG> __device__ __forceinline__ void att_elem(const f32x16& s, float& P, int j, int hi, bf16x8& pb0, bf16x8& pb1) {
    float w[16], T[4];
#pragma unroll
    for (int g = 0; g < 4; ++g) {
        float bt[4], kp[4];
#pragma unroll
        for (int e = 0; e < 4; ++e) {
            const int r = 4 * g + e;
            float nz; asm("v_min_f32_e64 %0, -%1, %2" : "=v"(nz) : "v"(s[r]), "s"(100.0f));
            const float ex = __builtin_amdgcn_exp2f(nz);
            float be = __builtin_amdgcn_rcpf(1.0f + ex); float ke = ex * be;
            if (DIAG && !(crow(r, hi) < j)) { be = 0.f; ke = 1.f; }
            bt[e] = be; kp[e] = ke;
        }
        const float s2 = kp[3], s1 = s2 * kp[2], s0 = s1 * kp[1];
        w[4 * g + 3] = bt[3]; w[4 * g + 2] = bt[2] * s2; w[4 * g + 1] = bt[1] * s1; w[4 * g + 0] = bt[0] * s0; T[g] = s0 * kp[0];
    }
    float sp3 = P, U[4], pr[4];
#pragma unroll
    for (int g = 0; g < 4; ++g) { U[g] = __shfl_xor(T[g], 32); pr[g] = T[g] * U[g]; }
    const float sp2 = sp3 * pr[3], sp1 = sp2 * pr[2], sp0 = sp1 * pr[1];
    P = sp0 * pr[0];
    { const float m3 = sp3 * (hi ? 1.0f : U[3]), m2 = sp2 * (hi ? 1.0f : U[2]), m1 = sp1 * (hi ? 1.0f : U[1]), m0 = sp0 * (hi ? 1.0f : U[0]);
#pragma unroll
      for (int e = 0; e < 4; ++e) { w[e] *= m0; w[4 + e] *= m1; w[8 + e] *= m2; w[12 + e] *= m3; } }
    u32x4 p0, p1;
    p0.x = pg8::cvt_pk_bf16(w[0], w[1]); p0.y = pg8::cvt_pk_bf16(w[2], w[3]); p0.z = pg8::cvt_pk_bf16(w[4], w[5]); p0.w = pg8::cvt_pk_bf16(w[6], w[7]);
    p1.x = pg8::cvt_pk_bf16(w[8], w[9]); p1.y = pg8::cvt_pk_bf16(w[10], w[11]); p1.z = pg8::cvt_pk_bf16(w[12], w[13]); p1.w = pg8::cvt_pk_bf16(w[14], w[15]);
    pb0 = __builtin_bit_cast(bf16x8, p0); pb1 = __builtin_bit_cast(bf16x8, p1);
}
__device__ __forceinline__ void attn_phase(LAS unsigned char* lds, const bf16_t* __restrict__ Q, const bf16_t* __restrict__ K, const bf16_t* __restrict__ V, bf16_t* __restrict__ O) {
    PHASE_IDS();
    LAS unsigned char* vl = lds + wave * (32 * VPITCH);
    const int j = lane & 31, hi = lane >> 5;
    const int g16 = lane >> 4, dsel = g16 & 1, qq = (lane & 15) >> 2, pp = lane & 3;
    const LAS unsigned char* vrd = vl + (4 * hi + qq) * VPITCH + (16 * dsel + 4 * pp) * 2;
#define VTR(off) __builtin_amdgcn_ds_read_tr16_b64_v4i16((LAS v4i16_t*)(vrd + (off)))
#define VFRAG(db, ks) ({ const v4i16_t lo_ = VTR((16 * (ks)) * VPITCH + (db) * 64), hi_ = VTR((16 * (ks) + 8) * VPITCH + (db) * 64); (bf16x8){lo_[0], lo_[1], lo_[2], lo_[3], hi_[0], hi_[1], hi_[2], hi_[3]}; })
#define ATT_LOADKV(KT) do { const bf16_t* Kp = K + (rowb + (KT) * 32 + j) * DM + h * 64 + hi * 8; \
            _Pragma("unroll") for (int d0 = 0; d0 < 4; ++d0) kf[d0] = *(const bf16x8*)(Kp + d0 * 16); \
            _Pragma("unroll") for (int i = 0; i < 4; ++i) { const int c = lane + 64 * i; vst[i] = *(const u32x4*)(V + (rowb + (KT) * 32 + (c >> 3)) * DM + h * 64 + (c & 7) * 8); } } while (0)
#define ATT_STAGEV() do { _Pragma("unroll") for (int i = 0; i < 4; ++i) { const int c = lane + 64 * i; *(LAS u32x4*)(vl + (c >> 3) * VPITCH + (c & 7) * 16) = vst[i]; } } while (0)
#define ATT_QK(S, QF) do { S = (f32x16){}; _Pragma("unroll") for (int d0 = 0; d0 < 4; ++d0) S = __builtin_amdgcn_mfma_f32_32x32x16_bf16(kf[d0], QF[d0], S, 0, 0, 0); } while (0)
#define ATT_PV(OA, OB, PB0, PB1) do { OA = __builtin_amdgcn_mfma_f32_32x32x16_bf16(v00, PB0, OA, 0, 0, 0); OA = __builtin_amdgcn_mfma_f32_32x32x16_bf16(v01, PB1, OA, 0, 0, 0); \
            OB = __builtin_amdgcn_mfma_f32_32x32x16_bf16(v10, PB0, OB, 0, 0, 0); OB = __builtin_amdgcn_mfma_f32_32x32x16_bf16(v11, PB1, OB, 0, 0, 0); } while (0)
#define ATT_ALIVE(P) (__builtin_amdgcn_ballot_w64((P) >= 1.17549435e-38f) != 0ull)
    for (int unit = gw; unit < BATCH * NHEAD * (SEQ / 64); unit += ngw) {
        const int qp = unit & 31, bh = unit >> 5, b = bh >> 4, h = bh & 15;
        const size_t rowb = (size_t)b * SEQ; const int q0 = qp * 64;
        bf16x8 qfa[4], qfb[4];
        { const bf16_t* Qp = Q + (rowb + q0 + j) * DM + h * 64 + hi * 8;
#pragma unroll
          for (int d0 = 0; d0 < 4; ++d0) { qfa[d0] = *(const bf16x8*)(Qp + d0 * 16); qfb[d0] = *(const bf16x8*)(Qp + 32 * DM + d0 * 16); } }
        f32x16 oa0 = {}, oa1 = {}, ob0 = {}, ob1 = {}; float Pa = 1.0f, Pb = 1.0f;
        bf16x8 kf[4]; u32x4 vst[4];
        const int top = 2 * qp + 1;
        { ATT_LOADKV(top); f32x16 sb; ATT_QK(sb, qfb); ATT_STAGEV(); asm volatile("s_nop 15\n\ts_nop 7" : "+v"(sb));
          bf16x8 pb0, pb1; att_elem<true>(sb, Pb, j, hi, pb0, pb1);
          asm volatile("s_waitcnt lgkmcnt(0)" ::: "memory");
          const bf16x8 v00 = VFRAG(0, 0), v01 = VFRAG(0, 1), v10 = VFRAG(1, 0), v11 = VFRAG(1, 1); ATT_PV(ob0, ob1, pb0, pb1);
          asm volatile("s_waitcnt lgkmcnt(0)" ::: "memory"); }
        { ATT_LOADKV(top - 1); f32x16 sa, sb; ATT_QK(sa, qfa); ATT_QK(sb, qfb); ATT_STAGEV(); asm volatile("s_nop 15\n\ts_nop 7" : "+v"(sa), "+v"(sb));
          bf16x8 pa0, pa1, pb0, pb1; att_elem<true>(sa, Pa, j, hi, pa0, pa1); att_elem<false>(sb, Pb, j, hi, pb0, pb1);
          asm volatile("s_waitcnt lgkmcnt(0)" ::: "memory");
          const bf16x8 v00 = VFRAG(0, 0), v01 = VFRAG(0, 1), v10 = VFRAG(1, 0), v11 = VFRAG(1, 1); ATT_PV(oa0, oa1, pa0, pa1); ATT_PV(ob0, ob1, pb0, pb1);
          asm volatile("s_waitcnt lgkmcnt(0)" ::: "memory"); }
        bool alive_a = ATT_ALIVE(Pa), alive_b = ATT_ALIVE(Pb);
        for (int kt = top - 2; kt >= 0 && (alive_a || alive_b); --kt) {
            ATT_LOADKV(kt);
            if (alive_a && alive_b) {
                f32x16 sa, sb; ATT_QK(sa, qfa); ATT_QK(sb, qfb); ATT_STAGEV(); asm volatile("s_nop 15\n\ts_nop 7" : "+v"(sa), "+v"(sb));
                bf16x8 pa0, pa1, pb0, pb1; att_elem<false>(sa, Pa, j, hi, pa0, pa1); att_elem<false>(sb, Pb, j, hi, pb0, pb1);
                asm volatile("s_waitcnt lgkmcnt(0)" ::: "memory");
                const bf16x8 v00 = VFRAG(0, 0), v01 = VFRAG(0, 1), v10 = VFRAG(1, 0), v11 = VFRAG(1, 1); ATT_PV(oa0, oa1, pa0, pa1); ATT_PV(ob0, ob1, pb0, pb1);
                alive_a = ATT_ALIVE(Pa); alive_b = ATT_ALIVE(Pb);
            } else if (alive_a) {
                f32x16 sa; ATT_QK(sa, qfa); ATT_STAGEV(); asm volatile("s_nop 15\n\ts_nop 7" : "+v"(sa));
                bf16x8 pa0, pa1; att_elem<false>(sa, Pa, j, hi, pa0, pa1);
                asm volatile("s_waitcnt lgkmcnt(0)" ::: "memory");
                const bf16x8 v00 = VFRAG(0, 0), v01 = VFRAG(0, 1), v10 = VFRAG(1, 0), v11 = VFRAG(1, 1); ATT_PV(oa0, oa1, pa0, pa1);
                alive_a = ATT_ALIVE(Pa);
            } else {
                f32x16 sb; ATT_QK(sb, qfb); ATT_STAGEV(); asm volatile("s_nop 15\n\ts_nop 7" : "+v"(sb));
                bf16x8 pb0, pb1; att_elem<false>(sb, Pb, j, hi, pb0, pb1);
                asm volatile("s_waitcnt lgkmcnt(0)" ::: "memory");
                const bf16x8 v00 = VFRAG(0, 0), v01 = VFRAG(0, 1), v10 = VFRAG(1, 0), v11 = VFRAG(1, 1); ATT_PV(ob0, ob1, pb0, pb1);
                alive_b = ATT_ALIVE(Pb);
            }
            asm volatile("s_waitcnt lgkmcnt(0)" ::: "memory");
        }
        bf16_t* Op = O + (rowb + q0 + j) * DM + h * 64 + 4 * hi;
#pragma unroll
        for (int g = 0; g < 4; ++g) {
            u32x2 a, c; a.x = pg8::cvt_pk_bf16(oa0[4 * g], oa0[4 * g + 1]); a.y = pg8::cvt_pk_bf16(oa0[4 * g + 2], oa0[4 * g + 3]);
            c.x = pg8::cvt_pk_bf16(oa1[4 * g], oa1[4 * g + 1]); c.y = pg8::cvt_pk_bf16(oa1[4 * g + 2], oa1[4 * g + 3]);
            *(u32x2*)(Op + 8 * g) = a; *(u32x2*)(Op + 32 + 8 * g) = c;
            a.x = pg8::cvt_pk_bf16(ob0[4 * g], ob0[4 * g + 1]); a.y = pg8::cvt_pk_bf16(ob0[4 * g + 2], ob0[4 * g + 3]);
            c.x = pg8::cvt_pk_bf16(ob1[4 * g], ob1[4 * g + 1]); c.y = pg8::cvt_pk_bf16(ob1[4 * g + 2], ob1[4 * g + 3]);
            *(u32x2*)(Op + 32 * DM + 8 * g) = a; *(u32x2*)(Op + 32 * DM + 32 + 8 * g) = c;
        }
    }
#undef VTR
#undef VFRAG
#undef ATT_LOADKV
#undef ATT_STAGEV
#undef ATT_QK
#undef ATT_PV
#undef ATT_ALIVE
}

constexpr int RG_WF = 0, RG_CONST = 16384, RG_TOT = RG_CONST + 8 * 64 * 4, RG_LDS_END = RG_TOT + 2 * 8 * 64 * 8;
template <int CTRL> __device__ __forceinline__ float dpp_f(float old, float src) {
    return __builtin_bit_cast(float, __builtin_amdgcn_update_dpp(__builtin_bit_cast(int, old), __builtin_bit_cast(int, src), CTRL, 0xf, 0xf, false));
}
__device__ __forceinline__ float sigmoid_f(float x) { const float e = __builtin_amdgcn_exp2f(-fminf(fmaxf(x, -80.f), 80.f) * 1.4426950408889634f); return __builtin_amdgcn_rcpf(1.0f + e); }
__device__ __forceinline__ void rg_phase(LAS unsigned char* lds, int li) {
    PHASE_IDS();
    const int tl = lane & 15, kg = lane >> 4;
    for (int unit = blockIdx.x; unit < BATCH * 16; unit += gridDim.x) {
        const int b = unit >> 4, hb = unit & 15;
        __syncthreads();
        for (int f = tid; f < 2 * 4 * 2 * 64; f += 512) {
            const int ln = f & 63, ks = (f >> 6) & 1, jb = (f >> 7) & 3, mat = f >> 9; const int jr = ln & 15, kgg = ln >> 4;
            const float* Wm = (mat ? KA->in[12] : KA->in[10]) + (size_t)li * 16 * 4096 + (size_t)hb * 4096;
            float v[8];
#pragma unroll
            for (int e = 0; e < 8; ++e) v[e] = Wm[(16 * (2 * ks + (e >> 2)) + 4 * kgg + (e & 3)) * 64 + 16 * jb + jr];
            u32x4 o; o.x = pk2(v[0], v[1]); o.y = pk2(v[2], v[3]); o.z = pk2(v[4], v[5]); o.w = pk2(v[6], v[7]);
            *(LAS u32x4*)(lds + RG_WF + f * 16) = o;
        }
        for (int c = tid; c < 8 * 64; c += 512) {
            const int k = c >> 6, ch = hb * 64 + (c & 63); float v;
            if (k < 4) v = (KA->in[8] + li * 4 * DM)[k * 1024 + ch]; else if (k == 4) v = (KA->in[9] + li * DM)[ch]; else if (k == 5) v = -1.4426950408889634f * (KA->in[11] + li * DM)[ch]; else if (k == 6) v = -1.4426950408889634f * (KA->in[13] + li * DM)[ch];
            else { const float l = (KA->in[14] + li * DM)[ch]; const float y = __builtin_amdgcn_exp2f(-fabsf(l) * 1.4426950408889634f);
                   const float l1p = (y < 0.03f) ? y * (1.0f - y * (0.5f - y * (0.33333334f - y * 0.25f))) : __builtin_amdgcn_logf(1.0f + y) * 0.6931471805599453f;
                   v = -16.0f * (fmaxf(-l, 0.f) + l1p); }
            ((LAS float*)(lds + RG_CONST))[c] = v;
        }
        __syncthreads();
        float hc[16];
#pragma unroll
        for (int i = 0; i < 16; ++i) hc[i] = 0.f;
        const size_t rowb = (size_t)b * SEQ; const int cbase = hb * 64 + 4 * kg;
        const bf16_t* __restrict__ G = (const bf16_t*)(KA->ws + WS_BIG); const bf16_t* __restrict__ XP = G + (size_t)M * DM; bf16_t* __restrict__ Y = (bf16_t*)(KA->ws + WS_BIG) + 2 * (size_t)M * DM;
#define RG_LOAD(chunk_, XPA, GVA) do { const int t_ = (chunk_) * 128 + wave * 16 + tl; \
            _Pragma("unroll") for (int tap = 0; tap < 4; ++tap) { const int ts = t_ - 3 + tap; const bf16_t* xr = XP + (rowb + (ts > 0 ? ts : 0)) * DM + cbase; \
                _Pragma("unroll") for (int jb = 0; jb < 4; ++jb) XPA[tap][jb] = *(const u32x2*)(xr + 16 * jb); } \
            if ((chunk_) == 0 && wave == 0) { _Pragma("unroll") for (int tap = 0; tap < 3; ++tap) if (t_ - 3 + tap < 0) { _Pragma("unroll") for (int jb = 0; jb < 4; ++jb) XPA[tap][jb] = (u32x2){0u, 0u}; } } \
            _Pragma("unroll") for (int jb = 0; jb < 4; ++jb) GVA[jb] = *(const u32x2*)(G + (rowb + t_) * DM + cbase + 16 * jb); } while (0)
        u32x2 xpn[4][4], gvn[4];
        RG_LOAD(0, xpn, gvn);
        for (int chunk = 0; chunk < SEQ / 128; ++chunk) {
            const int t = chunk * 128 + wave * 16 + tl;
            float xc[16];
#pragma unroll
            for (int jb = 0; jb < 4; ++jb) {
                const f32x4 cb = *(const LAS f32x4*)(lds + RG_CONST + (4 * 64 + 16 * jb + 4 * kg) * 4);
                xc[4 * jb] = cb.x; xc[4 * jb + 1] = cb.y; xc[4 * jb + 2] = cb.z; xc[4 * jb + 3] = cb.w;
            }
#pragma unroll
            for (int tap = 0; tap < 4; ++tap) {
#pragma unroll
                for (int jb = 0; jb < 4; ++jb) {
                    const u32x2 xv = xpn[tap][jb];
                    const f32x4 cw = *(const LAS f32x4*)(lds + RG_CONST + (tap * 64 + 16 * jb + 4 * kg) * 4);
                    xc[4 * jb] += cw.x * bf_lo(xv.x); xc[4 * jb + 1] += cw.y * bf_hi(xv.x); xc[4 * jb + 2] += cw.z * bf_lo(xv.y); xc[4 * jb + 3] += cw.w * bf_hi(xv.y);
                }
            }
            u32x2 gv[4];
#pragma unroll
            for (int jb = 0; jb < 4; ++jb) gv[jb] = gvn[jb];
            { const int cn = (chunk + 1 < SEQ / 128) ? chunk + 1 : chunk; RG_LOAD(cn, xpn, gvn); }
            u32x4 xb0, xb1;
            xb0.x = pg8::cvt_pk_bf16(xc[0], xc[1]); xb0.y = pg8::cvt_pk_bf16(xc[2], xc[3]); xb0.z = pg8::cvt_pk_bf16(xc[4], xc[5]); xb0.w = pg8::cvt_pk_bf16(xc[6], xc[7]);
            xb1.x = pg8::cvt_pk_bf16(xc[8], xc[9]); xb1.y = pg8::cvt_pk_bf16(xc[10], xc[11]); xb1.z = pg8::cvt_pk_bf16(xc[12], xc[13]); xb1.w = pg8::cvt_pk_bf16(xc[14], xc[15]);
            const bf16x8 bx0 = __builtin_bit_cast(bf16x8, xb0), bx1 = __builtin_bit_cast(bf16x8, xb1);
            float av[16], bv[16];
#pragma unroll
            for (int jb = 0; jb < 4; ++jb) {
                f32x4 ra = {0.f, 0.f, 0.f, 0.f}, ri = {0.f, 0.f, 0.f, 0.f};
                const bf16x8 wa0 = *(const LAS bf16x8*)(lds + RG_WF + (((0 * 4 + jb) * 2 + 0) * 64 + lane) * 16), wa1 = *(const LAS bf16x8*)(lds + RG_WF + (((0 * 4 + jb) * 2 + 1) * 64 + lane) * 16);
                const bf16x8 wx0 = *(const LAS bf16x8*)(lds + RG_WF + (((1 * 4 + jb) * 2 + 0) * 64 + lane) * 16), wx1 = *(const LAS bf16x8*)(lds + RG_WF + (((1 * 4 + jb) * 2 + 1) * 64 + lane) * 16);
                ra = __builtin_amdgcn_mfma_f32_16x16x32_bf16(wa0, bx0, ra, 0, 0, 0); ra = __builtin_amdgcn_mfma_f32_16x16x32_bf16(wa1, bx1, ra, 0, 0, 0);
                ri = __builtin_amdgcn_mfma_f32_16x16x32_bf16(wx0, bx0, ri, 0, 0, 0); ri = __builtin_amdgcn_mfma_f32_16x16x32_bf16(wx1, bx1, ri, 0, 0, 0);
                const f32x4 ba = *(const LAS f32x4*)(lds + RG_CONST + (5 * 64 + 16 * jb + 4 * kg) * 4), bxx = *(const LAS f32x4*)(lds + RG_CONST + (6 * 64 + 16 * jb + 4 * kg) * 4);
                const f32x4 lu = *(const LAS f32x4*)(lds + RG_CONST + (7 * 64 + 16 * jb + 4 * kg) * 4);
#pragma unroll
                for (int r = 0; r < 4; ++r) {
                    const float rg = __builtin_amdgcn_rcpf(1.0f + __builtin_amdgcn_exp2f(__builtin_fmaf(ra[r], -1.4426950408889634f, ba[r])));
                    const float ig = __builtin_amdgcn_rcpf(1.0f + __builtin_amdgcn_exp2f(__builtin_fmaf(ri[r], -1.4426950408889634f, bxx[r])));
                    const float x2 = rg * lu[r];
                    const float a = __builtin_amdgcn_exp2f(x2 * 0.7213475204444817f);
                    const float ser = -x2 * (1.0f + x2 * (0.5f + x2 * (0.16666667f + x2 * (0.041666668f + x2 * 0.008333334f))));
                    const float m2 = (x2 > -0.25f) ? ser : (1.0f - a * a);
                    av[4 * jb + r] = a; bv[4 * jb + r] = __builtin_amdgcn_sqrtf(fmaxf(m2, 0.f)) * (ig * xc[4 * jb + r]);
                }
            }
#define RG_SCAN8(N, A0, A1, A2, A3, A4, A5, A6, A7, B0, B1, B2, B3, B4, B5, B6, B7) asm volatile("s_nop 1\n\t" \
                "v_fmac_f32_dpp %8, %8, %0 row_shr:" #N " row_mask:0xf bank_mask:0xf\n\t" "v_fmac_f32_dpp %9, %9, %1 row_shr:" #N " row_mask:0xf bank_mask:0xf\n\t" \
                "v_fmac_f32_dpp %10, %10, %2 row_shr:" #N " row_mask:0xf bank_mask:0xf\n\t" "v_fmac_f32_dpp %11, %11, %3 row_shr:" #N " row_mask:0xf bank_mask:0xf\n\t" \
                "v_fmac_f32_dpp %12, %12, %4 row_shr:" #N " row_mask:0xf bank_mask:0xf\n\t" "v_fmac_f32_dpp %13, %13, %5 row_shr:" #N " row_mask:0xf bank_mask:0xf\n\t" \
                "v_fmac_f32_dpp %14, %14, %6 row_shr:" #N " row_mask:0xf bank_mask:0xf\n\t" "v_fmac_f32_dpp %15, %15, %7 row_shr:" #N " row_mask:0xf bank_mask:0xf\n\t" \
                "v_mul_f32_dpp %0, %0, %0 row_shr:" #N " row_mask:0xf bank_mask:0xf\n\t" "v_mul_f32_dpp %1, %1, %1 row_shr:" #N " row_mask:0xf bank_mask:0xf\n\t" \
                "v_mul_f32_dpp %2, %2, %2 row_shr:" #N " row_mask:0xf bank_mask:0xf\n\t" "v_mul_f32_dpp %3, %3, %3 row_shr:" #N " row_mask:0xf bank_mask:0xf\n\t" \
                "v_mul_f32_dpp %4, %4, %4 row_shr:" #N " row_mask:0xf bank_mask:0xf\n\t" "v_mul_f32_dpp %5, %5, %5 row_shr:" #N " row_mask:0xf bank_mask:0xf\n\t" \
                "v_mul_f32_dpp %6, %6, %6 row_shr:" #N " row_mask:0xf bank_mask:0xf\n\t" "v_mul_f32_dpp %7, %7, %7 row_shr:" #N " row_mask:0xf bank_mask:0xf" \
                : "+v"(A0), "+v"(A1), "+v"(A2), "+v"(A3), "+v"(A4), "+v"(A5), "+v"(A6), "+v"(A7), "+v"(B0), "+v"(B1), "+v"(B2), "+v"(B3), "+v"(B4), "+v"(B5), "+v"(B6), "+v"(B7))
#define RG_SCAN_ALL(N) do { RG_SCAN8(N, av[0], av[1], av[2], av[3], av[4], av[5], av[6], av[7], bv[0], bv[1], bv[2], bv[3], bv[4], bv[5], bv[6], bv[7]); \
                            RG_SCAN8(N, av[8], av[9], av[10], av[11], av[12], av[13], av[14], av[15], bv[8], bv[9], bv[10], bv[11], bv[12], bv[13], bv[14], bv[15]); } while (0)
            RG_SCAN_ALL(1); RG_SCAN_ALL(2); RG_SCAN_ALL(4); RG_SCAN_ALL(8);
#undef RG_SCAN_ALL
#undef RG_SCAN8
            LAS f32x2* tot = (LAS f32x2*)(lds + RG_TOT + (chunk & 1) * (8 * 64 * 8));
            if (tl == 15) {
#pragma unroll
                for (int jb = 0; jb < 4; ++jb)
#pragma unroll
                    for (int r = 0; r < 4; ++r) tot[wave * 64 + 16 * jb + 4 * kg + r] = (f32x2){av[4 * jb + r], bv[4 * jb + r]};
            }
            asm volatile("s_waitcnt lgkmcnt(0)" ::: "memory"); __builtin_amdgcn_s_barrier(); asm volatile("" ::: "memory");
#pragma unroll 1
            for (int w2 = 0; w2 < wave; ++w2) {
#pragma unroll
                for (int jb = 0; jb < 4; ++jb)
#pragma unroll
                    for (int r = 0; r < 4; ++r) { const f32x2 ab = tot[w2 * 64 + 16 * jb + 4 * kg + r]; hc[4 * jb + r] = ab.x * hc[4 * jb + r] + ab.y; }
            }
            float hin[16];
#pragma unroll
            for (int i = 0; i < 16; ++i) hin[i] = hc[i];
#pragma unroll 1
            for (int w2 = wave; w2 < 8; ++w2) {
#pragma unroll
                for (int jb = 0; jb < 4; ++jb)
#pragma unroll
                    for (int r = 0; r < 4; ++r) { const f32x2 ab = tot[w2 * 64 + 16 * jb + 4 * kg + r]; hc[4 * jb + r] = ab.x * hc[4 * jb + r] + ab.y; }
            }
            bf16_t* yr = Y + (rowb + t) * DM + cbase;
#pragma unroll
            for (int jb = 0; jb < 4; ++jb) {
                const float h0 = av[4 * jb] * hin[4 * jb] + bv[4 * jb], h1 = av[4 * jb + 1] * hin[4 * jb + 1] + bv[4 * jb + 1];
                const float h2 = av[4 * jb + 2] * hin[4 * jb + 2] + bv[4 * jb + 2], h3 = av[4 * jb + 3] * hin[4 * jb + 3] + bv[4 * jb + 3];
                u32x2 o; o.x = pg8::cvt_pk_bf16(h0 * bf_lo(gv[jb].x), h1 * bf_hi(gv[jb].x)); o.y = pg8::cvt_pk_bf16(h2 * bf_lo(gv[jb].y), h3 * bf_hi(gv[jb].y));
                *(u32x2*)(yr + 16 * jb) = o;
            }
        }
#undef RG_LOAD
    }
    __syncthreads();
}

template <int p> __device__ __forceinline__ void run_phase(LAS unsigned char* lds) {
    ArgsP ap = KA; unsigned char* ws = ap->ws;
    bf16_t* XB = (bf16_t*)(ws + WS_XB); float* SSQ = (float*)(ws + WS_SSQ); bf16_t* BIG = (bf16_t*)(ws + WS_BIG);
    const size_t MD = (size_t)M * DM;
    LAS float* RTAB = (LAS float*)(lds + 131072);
    int bx = blockIdx.x, Gn = gridDim.x; asm volatile("" : "+s"(bx), "+s"(Gn)); bx = __builtin_amdgcn_readfirstlane(bx); Gn = __builtin_amdgcn_readfirstlane(Gn);
    if constexpr (p == 0) { p0_prologue(lds); __syncthreads(); }
    else if constexpr (p == NPHASE - 1) { final_norm(ap->out, XB, SSQ, ap->in[16]); }
    else {
        constexpr int q = p - 1, layer = q / 5, k = q - 5 * layer, li = layer >> 1; constexpr bool even = (layer & 1) == 0;
        if constexpr (k == 0 || k == 3) {
            constexpr int N = (k == 3) ? FF : (even ? 3 * DM : 2 * DM), mode = (k == 3) ? 2 : (even ? 0 : 1), split = (k == 3) ? 0 : DM;
            const bf16_t* Bt = (k == 3) ? (const bf16_t*)(ws + WS_W1) + (size_t)layer * DM * FF : even ? (const bf16_t*)(ws + WS_WQKV) + (size_t)li * DM * 3 * DM : (const bf16_t*)(ws + WS_WIN) + (size_t)li * DM * 2 * DM;
            pg8::Gemm g{XB, Bt, M, N, DM}; pg8::FastOrder S; S.init(M, N, Gn, bx);
            pg8::fill_rstd(RTAB, SSQ, S);
            pg8::EpiAct E{BIG, split ? DM : FF, split, MD, RTAB, mode};
            pg8::gemm_phase<pg8::EpiAct, pg8::FastOrder, false, true>(lds, g, S, E);
        } else if constexpr (k == 2 || k == 4) {
            constexpr int K = (k == 4) ? FF : DM;
            const bf16_t* A = (k == 4) ? BIG : even ? BIG + 3 * MD : BIG + 2 * MD;
            const bf16_t* Bt = (k == 4) ? (const bf16_t*)(ws + WS_W2) + (size_t)layer * DM * FF : even ? (const bf16_t*)(ws + WS_WO) + (size_t)li * DM * DM : (const bf16_t*)(ws + WS_WRO) + (size_t)li * DM * DM;
            pg8::Gemm g{A, Bt, M, DM, K}; pg8::FastOrder S; S.init(M, DM, Gn, bx);
            pg8::EpiRes E{ws, WS_XB, WS_SSQ};
            pg8::gemm_phase<pg8::EpiRes, pg8::FastOrder, false, true>(lds, g, S, E);
        } else if constexpr (even) {
            attn_phase(lds, BIG, BIG + MD, BIG + 2 * MD, BIG + 3 * MD); __syncthreads();
        } else {
            rg_phase(lds, li);
        }
    }
}
constexpr int MISC_OFF = 131072 + 4096;
constexpr size_t WS_BAR = 0;
template <int p> __device__ __forceinline__ void run_from(LAS unsigned char* lds, cg::grid_group& grid) {
    if constexpr (p < NPHASE) {
        const int lo = KA->ph_lo, hi = KA->ph_hi;
        if (lo <= p && p < hi) {
#if defined(PROBE_DUP)
            if constexpr (p == PROBE_DUP) { for (int rep = 0; rep < PROBE_REPS; ++rep) { run_phase<p>(lds); grid.sync(); } }
#endif
            run_phase<p>(lds);
            if (p + 1 < hi) {
                if (hi > NPHASE) grid.sync();
                { XcdBarrier bar; bar.bar = (unsigned*)(KA->ws + WS_BAR); bar.x = xb_xcc_id(); bar.st = (volatile LAS unsigned*)(lds + MISC_OFF); xcd_barrier(bar); }
            }
        }
        run_from<p + 1>(lds, grid);
    }
}
__global__ void __launch_bounds__(NWAVES * 64, 2) hybrid_fwd(Args args_unused) {
    extern __shared__ __attribute__((aligned(16))) unsigned char lds_raw[];
    LAS unsigned char* lds = (LAS unsigned char*)lds_raw;
    cg::grid_group grid = cg::this_grid();
    if (threadIdx.x < 2) ((volatile LAS unsigned*)(lds + MISC_OFF))[threadIdx.x] = 0u;
    __syncthreads();
    if (KA->ph_hi - KA->ph_lo > 2) (void)xcd_barrier_post((unsigned*)(KA->ws + WS_BAR), (volatile LAS unsigned*)(lds + MISC_OFF));
    run_from<0>(lds, grid);
}

extern "C" void kernel_launch(void* const* d_in, const int* in_sizes, int n_in, void* d_out, int out_size, void* d_ws, size_t ws_size, hipStream_t stream) {
    static int grid = 0;
    if (grid == 0) {
        if (n_in != 17 || in_sizes[0] != M * DM || out_size != M * DM || ws_size < WS_END) { fprintf(stderr, "kernel_launch: unexpected shapes (n_in %d, in0 %d, out %d, ws %zu); nothing launched\n", n_in, n_in > 0 ? in_sizes[0] : -1, out_size, ws_size); grid = -1; return; }
        int dev = 0, cus = 0, per_cu = 0;
        if (hipGetDevice(&dev) != hipSuccess || hipDeviceGetAttribute(&cus, hipDeviceAttributeMultiprocessorCount, dev) != hipSuccess) { grid = -1; return; }
        if (hipFuncSetAttribute((const void*)hybrid_fwd, hipFuncAttributeMaxDynamicSharedMemorySize, LDS_BYTES) != hipSuccess) { fprintf(stderr, "kernel_launch: hipFuncSetAttribute failed\n"); grid = -1; return; }
        if (hipOccupancyMaxActiveBlocksPerMultiprocessor(&per_cu, (const void*)hybrid_fwd, NWAVES * 64, LDS_BYTES) != hipSuccess || per_cu < 1) { fprintf(stderr, "kernel_launch: occupancy query says %d\n", per_cu); per_cu = 1; }
        (void)hipGetLastError();
        grid = cus * per_cu;
    }
    if (grid < 0) return;
    Args a{};
    for (int i = 0; i < 17; ++i) a.in[i] = (const float*)d_in[i];
    a.out = (float*)d_out; a.ws = (unsigned char*)d_ws;
#if MK_ONE_LAUNCH
    a.ph_lo = 0; a.ph_hi = NPHASE;
    if (hipMemsetAsync((char*)d_ws + WS_BAR, 0, 16384, stream) != hipSuccess) { fprintf(stderr, "kernel_launch: hipMemsetAsync failed\n"); return; }
    { void* kargs[] = {&a}; hipError_t e = hipLaunchCooperativeKernel((const void*)hybrid_fwd, dim3(grid), dim3(NWAVES * 64), kargs, LDS_BYTES, stream);
      if (e != hipSuccess) fprintf(stderr, "cooperative launch failed: %s (grid %d)\n", hipGetErrorString(e), grid); }
#else
    for (int p = 0; p < NPHASE; ++p) {
        a.ph_lo = p; a.ph_hi = p + 1;
        void* kargs[] = {&a}; hipError_t e = hipLaunchCooperativeKernel((const void*)hybrid_fwd, dim3(grid), dim3(NWAVES * 64), kargs, LDS_BYTES, stream);
        if (e != hipSuccess) { fprintf(stderr, "launch %d failed: %s (grid %d)\n", p, hipGetErrorString(e), grid); break; }
    }
#endif
}
```

```cpp
#include <hip/hip_runtime.h>
#include <cstdio>
#include <cstdint>
#include <cmath>
namespace pg8 {
#define PG8_LAS __attribute__((address_space(3)))
typedef unsigned short bf16_t;
typedef short bf16x8 __attribute__((ext_vector_type(8)));
typedef float f32x4 __attribute__((ext_vector_type(4)));
typedef unsigned u32x4 __attribute__((ext_vector_type(4)));
constexpr int BM = 256, BK = 64, HALF = 128, HTB = HALF * BK * 2  , STAGE_BYTES = 8 * HTB, NXCD = 8, WGM = 8;

__host__ __device__ __forceinline__ int lds_byte(int r, int c) { const int st = (r >> 4) * 2 + (c >> 5), rr = r & 15, cc = c & 31, ob = rr * 64 + cc * 2; return st * 1024 + (ob ^ (((ob >> 9) & 1) << 5)); }
__host__ __device__ __forceinline__ void stage_rc(int b, int& R, int& C) { const int st = b / 1024, sb = b % 1024, swz = sb ^ (((sb >> 9) & 1) << 5); R = (st >> 1) * 16 + swz / 64; C = (st & 1) * 32 + (swz % 64) / 2; }
__host__ __device__ __forceinline__ int perm32(int rho) { const int n = rho >> 4, i = rho & 15; return 8 * (i >> 2) + 4 * n + (i & 3); }

struct Unit { int pm, pn; };
struct Gemm { const bf16_t* A; const bf16_t* Bt; int M, N, K; };

struct StaticOrder {
    int nM, nN, nwg, G, c;
    __host__ __device__ void init(int M, int N, int G_, int c_) { nM = M / BM; nN = N / BM; nwg = nM * nN; G = G_; c = c_; }
    __host__ __device__ bool next(int i, Unit& u) const {
        const long L = (long)i * G + c; if (L >= nwg) return false;
        int wgid = (int)L; { const int q = nwg / NXCD, r = nwg % NXCD, xcd = wgid % NXCD, off = wgid / NXCD; wgid = (xcd < r ? xcd * (q + 1) : r * (q + 1) + (xcd - r) * q) + off; }
        const int nig = WGM * nN, gid = wgid / nig, fm = gid * WGM, gsz = (nM - fm) < WGM ? (nM - fm) : WGM;
        u.pm = fm + ((wgid % nig) % gsz); u.pn = (wgid % nig) / gsz; return true;
    }
    __device__ __forceinline__ void a_ready(const Unit&) const {}
    __device__ __forceinline__ void done(const Unit&) const {}
};

__device__ __forceinline__ unsigned cvt_pk_bf16(float lo, float hi) { unsigned r; asm volatile("v_cvt_pk_bf16_f32 %0, %1, %2" : "=v"(r) : "v"(lo), "v"(hi)); return r; }
typedef unsigned u32x4 __attribute__((ext_vector_type(4)));
constexpr float RMS_EPS = 1e-6f;
constexpr float QSCALE = 0.125f * 1.4426950408889634f;
__device__ __forceinline__ float row_rstd(const float* ssq, int row) {
    const f32x4* sp = (const f32x4*)(ssq + (size_t)row * 16);
    const f32x4 a = sp[0], b = sp[1], c = sp[2], d = sp[3];
    const f32x4 s = (a + b) + (c + d);
    return __builtin_amdgcn_rsqf(((s.x + s.y) + (s.z + s.w)) * (1.0f / 1024.0f) + RMS_EPS);
}
__device__ __forceinline__ float gelu_tanh(float x) {
    const float u = x * (1.0f + 0.044715f * x * x) * (2.0f * 0.7978845608028654f * 1.4426950408889634f);
    const float e = __builtin_amdgcn_exp2f(-fminf(fmaxf(u, -100.f), 100.f));
    return x * __builtin_amdgcn_rcpf(1.0f + e);
}
struct EpiAct {
    static constexpr bool PERM = true, AFTER_DRAIN = false;
    bf16_t* O; int ldc; int split_cols; size_t split_stride; const PG8_LAS float* rtab; int MODE;
    __device__ __forceinline__ void operator()(const f32x4 (&acc)[2][2][4][2], const Unit& u, int wr, int wc, int fr, int fq) const {
        { int t2 = threadIdx.x; asm volatile("" : "+v"(t2)); fr = t2 & 15; fq = (t2 >> 4) & 3; }
        const int row0 = u.pm * BM + wr * 64 + fr; int colt = u.pn * BM; bf16_t* base = O; int t = 0;
        if (split_cols) { t = colt >> 10; base += (size_t)t * split_stride; colt &= 1023; }
        const int col0 = colt + wc * 32 + 8 * fq;
#pragma unroll
        for (int ai = 0; ai < 2; ++ai)
#pragma unroll
            for (int m = 0; m < 4; ++m) {
                const int row = row0 + ai * HALF + m * 16;
                float rs = rtab[((u.pm >> 3) & 1) * 256 + (row & 255)];
                if (MODE == 0 && t == 0) rs *= QSCALE;
                bf16_t* rowp = base + (size_t)row * ldc + col0;
#pragma unroll
                for (int bj = 0; bj < 2; ++bj) {
                    f32x4 v0 = acc[ai][bj][m][0] * rs, v1 = acc[ai][bj][m][1] * rs;
                    if (MODE == 1) { if (t == 0) {
#pragma unroll
                        for (int e = 0; e < 4; ++e) { v0[e] = gelu_tanh(v0[e]); v1[e] = gelu_tanh(v1[e]); } } }
                    if (MODE == 2) {
#pragma unroll
                        for (int e = 0; e < 4; ++e) { const float a = fmaxf(v0[e], 0.f), b = fmaxf(v1[e], 0.f); v0[e] = a * a; v1[e] = b * b; } }
                    u32x4 w; w.x = cvt_pk_bf16(v0[0], v0[1]); w.y = cvt_pk_bf16(v0[2], v0[3]); w.z = cvt_pk_bf16(v1[0], v1[1]); w.w = cvt_pk_bf16(v1[2], v1[3]);
                    *(u32x4*)(rowp + bj * HALF) = w;
                }
            }
    }
};
struct EpiRes {
    static constexpr bool PERM = true, AFTER_DRAIN = false;
    unsigned char* wsb; size_t xb_off, ssq_off;
    __device__ __forceinline__ void operator()(const f32x4 (&acc)[2][2][4][2], const Unit& u, int wr, int wc, int fr, int fq) const {
        { int t2 = threadIdx.x; asm volatile("" : "+v"(t2)); fr = t2 & 15; fq = (t2 >> 4) & 3; }
        bf16_t* xb = (bf16_t*)(wsb + xb_off); float* ssq = (float*)(wsb + ssq_off);
        const int row0 = u.pm * BM + wr * 64 + fr; const int col0 = u.pn * BM + wc * 32 + 8 * fq;
        u32x4 pre[2][4][2];
#pragma unroll
        for (int ai = 0; ai < 2; ++ai)
#pragma unroll
            for (int m = 0; m < 4; ++m)
#pragma unroll
                for (int bj = 0; bj < 2; ++bj) pre[ai][m][bj] = *(const u32x4*)(xb + (size_t)(row0 + ai * HALF + m * 16) * 1024 + col0 + bj * HALF);
#pragma unroll
        for (int ai = 0; ai < 2; ++ai)
#pragma unroll
            for (int m = 0; m < 4; ++m) {
                const int row = row0 + ai * HALF + m * 16; float q = 0.f;
#pragma unroll
                for (int bj = 0; bj < 2; ++bj) {
                    const u32x4 b = pre[ai][m][bj];
                    f32x4 v0 = acc[ai][bj][m][0], v1 = acc[ai][bj][m][1];
                    v0[0] += __builtin_bit_cast(float, b.x << 16); v0[1] += __builtin_bit_cast(float, b.x & 0xffff0000u); v0[2] += __builtin_bit_cast(float, b.y << 16); v0[3] += __builtin_bit_cast(float, b.y & 0xffff0000u);
                    v1[0] += __builtin_bit_cast(float, b.z << 16); v1[1] += __builtin_bit_cast(float, b.z & 0xffff0000u); v1[2] += __builtin_bit_cast(float, b.w << 16); v1[3] += __builtin_bit_cast(float, b.w & 0xffff0000u);
                    q += (v0[0] * v0[0] + v0[1] * v0[1]) + (v0[2] * v0[2] + v0[3] * v0[3]) + (v1[0] * v1[0] + v1[1] * v1[1]) + (v1[2] * v1[2] + v1[3] * v1[3]);
                    u32x4 w; w.x = cvt_pk_bf16(v0[0], v0[1]); w.y = cvt_pk_bf16(v0[2], v0[3]); w.z = cvt_pk_bf16(v1[0], v1[1]); w.w = cvt_pk_bf16(v1[2], v1[3]);
                    *(u32x4*)(xb + (size_t)row * 1024 + col0 + bj * HALF) = w;
                }
                q += __shfl_xor(q, 16); q += __shfl_xor(q, 32);
                if (fq == 0) ssq[(size_t)row * 16 + u.pn * 4 + wc] = q;
            }
    }
};
template <class Sched> __device__ __forceinline__ void fill_rstd(PG8_LAS float* rtab, const float* ssq, const Sched& S) {
    int last0 = -1, last1 = -1; Unit u; int tx = threadIdx.x; asm volatile("" : "+v"(tx));
    for (int i = 0; S.next(i, u); ++i) {
        const int slot = (u.pm >> 3) & 1; const int last = slot ? last1 : last0;
        if (last != u.pm) { if (tx < 256) rtab[slot * 256 + tx] = row_rstd(ssq, u.pm * BM + tx); if (slot) last1 = u.pm; else last0 = u.pm; }
    }
    __syncthreads();
}

struct FastOrder {
    int nq, sh, nwg, q, G, c;
    __device__ __forceinline__ void init(int M_, int N_, int G_, int c_) { const int nN = N_ / BM; nq = nN >> 2; sh = nq >> 1; nwg = (M_ / BM) * nN; q = nwg >> 3; G = G_; c = c_; }
    __device__ __forceinline__ bool next(int i, Unit& u) const {
        const int L = i * G + c; if (L >= nwg) return false;
        const int wgid = (L & 7) * q + (L >> 3);
        const int y = wgid >> 5;
        const int gid = (nq == 3) ? ((y * 43691) >> 17) : (y >> sh);
        const int rem = wgid - gid * (nq << 5);
        u.pm = gid * 8 + (rem & 7); u.pn = rem >> 3; return true;
    }
    __device__ __forceinline__ void a_ready(const Unit&) const {}
    __device__ __forceinline__ void done(const Unit&) const {}
};
template <class Epi, class Sched, bool ALIGN_EPI = false, bool SP2 = false>
__device__ __forceinline__ void gemm_phase(PG8_LAS unsigned char* lds, const Gemm g, const Sched& S, const Epi& E) {
    int tid_ = threadIdx.x; asm volatile("" : "+v"(tid_));
    const int tid = tid_, wid = __builtin_amdgcn_readfirstlane(tid >> 6), lane = tid & 63, wr = wid >> 2, wc = wid & 3, fr = lane & 15, fq = lane >> 4;
    const int K = g.K, nt = K / BK;
    unsigned voffA, voffB;
    { int R, C; stage_rc(tid * 16, R, C); const int Rb = Epi::PERM ? ((R & ~31) + perm32(R & 31)) : R;
        voffA = (unsigned)(R * K + C) * 2u; voffB = (unsigned)(Rb * K + C) * 2u; }
    const size_t qstep = (size_t)64 * K * 2;
    const size_t kstep = (size_t)(BK * 2);
    const size_t hstep = (size_t)HALF * K * 2;
    const size_t tstep = 2 * hstep;
    const unsigned ldsw = (unsigned)wid * 1024u;
    const int aoff = lds_byte(wr * 64 + fr, fq * 8), boff = lds_byte(wc * 32 + fr, fq * 8);
#define PG8_SA(b, h) (((b) * 2 + (h)) * HTB)
#define PG8_SB(b, h) ((4 + (b) * 2 + (h)) * HTB)
#define PG8_STAGE(bufoff, gbase, voff) do { _Pragma("unroll") for (int _i = 0; _i < 2; ++_i) \
        __builtin_amdgcn_global_load_lds((const unsigned*)((const char*)(gbase) + _i * qstep + (voff)), (PG8_LAS unsigned*)(lds + (bufoff) + ldsw + _i * 8192), 16, 0, 0); } while (0)
#define PG8_LDA(dst, b, h) do { _Pragma("unroll") for (int m = 0; m < 4; ++m) _Pragma("unroll") for (int k = 0; k < 2; ++k) dst[m][k] = *(const PG8_LAS bf16x8*)(lds + PG8_SA(b, h) + aoff + m * 2048 + k * 1024); } while (0)
#define PG8_LDB(dst, b, h) do { _Pragma("unroll") for (int n = 0; n < 2; ++n) _Pragma("unroll") for (int k = 0; k < 2; ++k) dst[n][k] = *(const PG8_LAS bf16x8*)(lds + PG8_SB(b, h) + boff + n * 2048 + k * 1024); } while (0)
#define PG8_MMA(ai, bj, At, Bt) do { __builtin_amdgcn_s_setprio(1); _Pragma("unroll") for (int m = 0; m < 4; ++m) _Pragma("unroll") for (int n = 0; n < 2; ++n) _Pragma("unroll") for (int k = 0; k < 2; ++k) \
        acc[ai][bj][m][n] = __builtin_amdgcn_mfma_f32_16x16x32_bf16(Bt[n][k], At[m][k], acc[ai][bj][m][n], 0, 0, 0); __builtin_amdgcn_s_setprio(0); } while (0)
#define PG8_WAIT_V(n) asm volatile("s_waitcnt vmcnt(" #n ")" ::: "memory")
#define PG8_WAIT_L(n) asm volatile("s_waitcnt lgkmcnt(" #n ")" ::: "memory")
#define PG8_BAR __builtin_amdgcn_s_barrier()
#define PG8_SCHED __builtin_amdgcn_sched_barrier(0)
    Unit cur, nxt; int ui = 0;
    if (!S.next(0, cur)) return;
    f32x4 acc[2][2][4][2];
#pragma unroll
    for (int a = 0; a < 2; ++a)
#pragma unroll
        for (int b = 0; b < 2; ++b)
#pragma unroll
            for (int m = 0; m < 4; ++m)
#pragma unroll
                for (int n = 0; n < 2; ++n) acc[a][b][m][n] = (f32x4){0.f, 0.f, 0.f, 0.f};
    bf16x8 At[4][2], B0[2][2], B1[2][2];
    const char* cA = (const char*)g.A + (size_t)cur.pm * tstep; const char* cB = (const char*)g.Bt + (size_t)cur.pn * tstep;
    S.a_ready(cur);
    if constexpr (SP2) {
        PG8_STAGE(PG8_SB(0, 0), cB, voffB); PG8_STAGE(PG8_SB(0, 1), cB + hstep, voffB); PG8_STAGE(PG8_SA(0, 0), cA, voffA); PG8_STAGE(PG8_SA(0, 1), cA + hstep, voffA);
        if (wr == 1) PG8_BAR;
        PG8_WAIT_V(2); PG8_BAR;
        PG8_STAGE(PG8_SB(1, 0), cB + kstep, voffB); PG8_STAGE(PG8_SA(1, 0), cA + kstep, voffA); PG8_STAGE(PG8_SB(1, 1), cB + hstep + kstep, voffB);
        PG8_WAIT_V(6); PG8_BAR;
    } else {
        PG8_STAGE(PG8_SB(0, 0), cB, voffB); PG8_STAGE(PG8_SA(0, 0), cA, voffA); PG8_STAGE(PG8_SB(0, 1), cB + hstep, voffB); PG8_STAGE(PG8_SA(0, 1), cA + hstep, voffA);
        if (wr == 1) PG8_BAR;
        PG8_WAIT_V(4); PG8_BAR;
        PG8_STAGE(PG8_SB(1, 0), cB + kstep, voffB); PG8_STAGE(PG8_SA(1, 0), cA + kstep, voffA); PG8_STAGE(PG8_SB(1, 1), cB + hstep + kstep, voffB);
        PG8_WAIT_V(6); PG8_BAR;
    }
    for (;;) {
        const bool has_next = S.next(ui + 1, nxt);
        const char* nA = has_next ? (const char*)g.A + (size_t)nxt.pm * tstep : cA; const char* nB = has_next ? (const char*)g.Bt + (size_t)nxt.pn * tstep : cB;
        for (int t = 0; t < nt; t += 2) {
            const bool last = (t == nt - 2);
            const char* a1 = cA + (size_t)(t + 1) * kstep;
            const char* a2 = last ? nA : cA + (size_t)(t + 2) * kstep; const char* b2 = last ? nB : cB + (size_t)(t + 2) * kstep;
            const char* a3 = a2 + kstep; const char* b3 = b2 + kstep;
            if (last && has_next) S.a_ready(nxt);
            if constexpr (SP2) {
            PG8_LDB(B0, 0, 0); PG8_LDB(B1, 0, 1); PG8_SCHED; PG8_LDA(At, 0, 0); PG8_STAGE(PG8_SA(1, 1), a1 + hstep, voffA);
            PG8_WAIT_V(8); PG8_WAIT_L(0); PG8_BAR; PG8_MMA(0, 0, At, B0); PG8_MMA(0, 1, At, B1); PG8_BAR; PG8_SCHED;
            PG8_LDA(At, 0, 1); PG8_STAGE(PG8_SB(0, 0), b2, voffB); PG8_STAGE(PG8_SB(0, 1), b2 + hstep, voffB); PG8_STAGE(PG8_SA(0, 0), a2, voffA);
            PG8_WAIT_V(8); PG8_WAIT_L(0); PG8_BAR; PG8_MMA(1, 0, At, B0); PG8_MMA(1, 1, At, B1); PG8_BAR; PG8_SCHED;
            PG8_LDB(B0, 1, 0); PG8_LDB(B1, 1, 1); PG8_SCHED; PG8_LDA(At, 1, 0); PG8_STAGE(PG8_SA(0, 1), a2 + hstep, voffA);
            PG8_WAIT_V(8); PG8_WAIT_L(0); PG8_BAR; PG8_MMA(0, 0, At, B0); PG8_MMA(0, 1, At, B1); PG8_BAR; PG8_SCHED;
            PG8_LDA(At, 1, 1); PG8_STAGE(PG8_SB(1, 0), b3, voffB); PG8_STAGE(PG8_SB(1, 1), b3 + hstep, voffB); PG8_STAGE(PG8_SA(1, 0), a3, voffA);
            PG8_WAIT_V(8); PG8_WAIT_L(0); PG8_BAR; PG8_MMA(1, 0, At, B0); PG8_MMA(1, 1, At, B1); PG8_BAR; PG8_SCHED;
            } else {
            PG8_LDB(B0, 0, 0); PG8_SCHED; PG8_LDA(At, 0, 0); PG8_STAGE(PG8_SA(1, 1), a1 + hstep, voffA);
            PG8_WAIT_L(8); PG8_BAR; PG8_WAIT_L(0); PG8_MMA(0, 0, At, B0); PG8_BAR; PG8_SCHED;
            PG8_LDB(B1, 0, 1); PG8_STAGE(PG8_SB(0, 0), b2, voffB);
            PG8_BAR; PG8_WAIT_L(0); PG8_MMA(0, 1, At, B1); PG8_BAR;
            PG8_LDA(At, 0, 1); PG8_STAGE(PG8_SA(0, 0), a2, voffA);
            PG8_BAR; PG8_WAIT_L(0); PG8_MMA(1, 0, At, B0); PG8_BAR; PG8_SCHED;
            PG8_STAGE(PG8_SB(0, 1), b2 + hstep, voffB);
            PG8_WAIT_V(6); PG8_BAR; PG8_MMA(1, 1, At, B1); PG8_BAR;
            PG8_LDB(B0, 1, 0); PG8_SCHED; PG8_LDA(At, 1, 0); PG8_STAGE(PG8_SA(0, 1), a2 + hstep, voffA);
            PG8_WAIT_L(8); PG8_BAR; PG8_WAIT_L(0); PG8_MMA(0, 0, At, B0); PG8_BAR; PG8_SCHED;
            PG8_LDB(B1, 1, 1); PG8_STAGE(PG8_SB(1, 0), b3, voffB);
            PG8_BAR; PG8_WAIT_L(0); PG8_MMA(0, 1, At, B1); PG8_BAR;
            PG8_LDA(At, 1, 1); PG8_STAGE(PG8_SA(1, 0), a3, voffA);
            PG8_BAR; PG8_WAIT_L(0); PG8_MMA(1, 0, At, B0); PG8_BAR; PG8_SCHED;
            PG8_STAGE(PG8_SB(1, 1), b3 + hstep, voffB);
            PG8_WAIT_V(6); PG8_BAR; PG8_MMA(1, 1, At, B1); PG8_BAR;
            }
        }
        if constexpr (ALIGN_EPI) { if (wr == 0) PG8_BAR; }
        if constexpr (!Epi::AFTER_DRAIN) { E(acc, cur, wr, wc, fr, fq); S.done(cur); }
        if (!has_next) break;
#pragma unroll
        for (int a = 0; a < 2; ++a)
#pragma unroll
            for (int b = 0; b < 2; ++b)
#pragma unroll
                for (int m = 0; m < 4; ++m)
#pragma unroll
                    for (int n = 0; n < 2; ++n) acc[a][b][m][n] = (f32x4){0.f, 0.f, 0.f, 0.f};
        cur = nxt; cA = nA; cB = nB; ++ui;
        if constexpr (ALIGN_EPI) { if (wr == 1) PG8_BAR; }
    }
    PG8_WAIT_V(0);
    if constexpr (!ALIGN_EPI) { if (wr == 0) PG8_BAR; }
    PG8_BAR;
    if constexpr (Epi::AFTER_DRAIN) { E.fused(acc, cur, wr, wc, fr, fq, lds, wid, lane); S.done(cur); }
#undef PG8_SA
#undef PG8_SB
#undef PG8_STAGE
#undef PG8_LDA
#undef PG8_LDB
#undef PG8_MMA
#undef PG8_WAIT_V
#undef PG8_WAIT_L
#undef PG8_BAR
#undef PG8_SCHED
}
}
#define LAS __attribute__((address_space(3)))
#define XB_TMO      128
#define XB_XCNT(j)  (256  + 64 * (j))
#define XB_XSUB(j)  (1280 + 64 * (j))
#define XB_XGEN(j)  (2304 + 64 * (j))
#define XB_TOP      3328
#define XB_TOPGEN   3392
#define XCD_BAR_WORDS 3456
#define XB_SPIN_CAP (1u << 22)

__device__ __forceinline__ unsigned xb_ld(unsigned* p)              { return __hip_atomic_load(p, __ATOMIC_RELAXED, __HIP_MEMORY_SCOPE_AGENT); }
__device__ __forceinline__ unsigned xb_add(unsigned* p, unsigned v) { return __hip_atomic_fetch_add(p, v, __ATOMIC_RELAXED, __HIP_MEMORY_SCOPE_AGENT); }
__device__ __forceinline__ unsigned xb_xcc_id() { return (unsigned)__builtin_amdgcn_s_getreg((3 << 11) | 20) & 0xFu; }
#define XB_SPIN(cond, bar) do { unsigned _sp = 0; while (cond) { __builtin_amdgcn_s_sleep(1); \
    if ((++_sp & 255u) == 0u) { if (xb_ld(&(bar)[XB_TMO])) break; if (_sp > XB_SPIN_CAP) { atomicAdd(&(bar)[XB_TMO], 1u); break; } } } } while (0)

struct XcdBarrier {
    unsigned* bar; unsigned x;
    volatile LAS unsigned* st;
};

__device__ __forceinline__ XcdBarrier xcd_barrier_post(unsigned* bar, volatile LAS unsigned* st) {
    XcdBarrier b; b.bar = bar; b.x = xb_xcc_id(); b.st = st;
    if (threadIdx.x == 0) (void)xb_add(&bar[XB_XCNT(b.x)], 1u);
    return b;
}
__device__ __forceinline__ void xcd_barrier_complete(unsigned* bar, unsigned x, unsigned& nloc, unsigned& nx) {
    const unsigned G = gridDim.x * gridDim.y * gridDim.z;
    unsigned sum, cnt, mine, sp = 0u;
    for (;;) {
        sum = 0u; cnt = 0u; mine = 0u;
#pragma unroll
        for (unsigned j = 0; j < 16; ++j) { const unsigned c = xb_ld(&bar[XB_XCNT(j)]); sum += c; cnt += (c > 0u) ? 1u : 0u; mine = (j == x) ? c : mine; }
        if (sum == G) break;
        __builtin_amdgcn_s_sleep(1);
        if ((++sp & 255u) == 0u) { if (xb_ld(&bar[XB_TMO])) break; if (sp > XB_SPIN_CAP) { atomicAdd(&bar[XB_TMO], 1u); break; } }
    }
    nloc = mine > 0u ? mine : 1u; nx = cnt > 0u ? cnt : 1u;
}

__device__ __forceinline__ void xcd_barrier(const XcdBarrier& b) {
    asm volatile("s_waitcnt vmcnt(0)" ::: "memory");
    __syncthreads();
    if (threadIdx.x == 0) {
        unsigned* bar = b.bar;
        __builtin_amdgcn_s_waitcnt(0);
        unsigned nloc = b.st[0], nx = b.st[1];
        if (nloc == 0u) { xcd_barrier_complete(bar, b.x, nloc, nx); b.st[0] = nloc; b.st[1] = nx; }
        const unsigned old = xb_add(&bar[XB_XSUB(b.x)], 1u);
        const unsigned gen = old / nloc;
        if (old + 1u == (gen + 1u) * nloc) {
            __builtin_amdgcn_fence(__ATOMIC_RELEASE, "agent");
            asm volatile("s_waitcnt vmcnt(0)" ::: "memory");
            const unsigned og = xb_add(&bar[XB_TOP], 1u);
            const unsigned tg = og / nx;
            if (og + 1u == (tg + 1u) * nx) xb_add(&bar[XB_TOPGEN], 1u);
            else XB_SPIN(xb_ld(&bar[XB_TOPGEN]) == tg, bar);
            __builtin_amdgcn_fence(__ATOMIC_ACQUIRE, "agent");
            xb_add(&bar[XB_XGEN(b.x)], 1u);
            asm volatile("s_waitcnt vmcnt(0)" ::: "memory");
        } else {
            XB_SPIN(xb_ld(&bar[XB_XGEN(b.x)]) == gen, bar);
            __builtin_amdgcn_fence(__ATOMIC_ACQUIRE, "agent");
            asm volatile("s_waitcnt vmcnt(0)" ::: "memory");
        }
    }
    __syncthreads();
}

#include <hip/hip_cooperative_groups.h>
namespace cg = cooperative_groups;
typedef pg8::bf16_t bf16_t;
typedef pg8::bf16x8 bf16x8;
typedef pg8::f32x4 f32x4;
typedef pg8::u32x4 u32x4;
typedef float f32x16 __attribute__((ext_vector_type(16)));
typedef float f32x2 __attribute__((ext_vector_type(2)));
typedef unsigned u32x2 __attribute__((ext_vector_type(2)));
typedef short v4i16_t __attribute__((ext_vector_type(4)));

constexpr int BATCH = 16, SEQ = 2048, DM = 1024, M = BATCH * SEQ, DEPTH = 4, FF = 4096, NHEAD = 16;
constexpr int NWAVES = 8;
#ifndef MK_ONE_LAUNCH
#define MK_ONE_LAUNCH 1
#endif
constexpr size_t MiB = 1u << 20;
constexpr size_t WS_SSQ = 1 * MiB;
constexpr size_t WS_W1 = 4 * MiB, WS_W2 = 36 * MiB, WS_WQKV = 68 * MiB, WS_WO = 80 * MiB, WS_WIN = 84 * MiB, WS_WRO = 92 * MiB;
constexpr size_t WS_XB = 96 * MiB;
constexpr size_t WS_BIG = 160 * MiB;
constexpr size_t WS_END = 416 * MiB;
constexpr int LDS_BYTES = 147456;
constexpr int NPHASE = 1 + 5 * DEPTH + 1;

__device__ __forceinline__ unsigned f2bf(float f) { unsigned u = __builtin_bit_cast(unsigned, f); return (u + 0x7fffu + ((u >> 16) & 1u)) >> 16; }
__device__ __forceinline__ unsigned pk2(float lo, float hi) { return f2bf(lo) | (f2bf(hi) << 16); }
__device__ __forceinline__ float bf_lo(unsigned w) { return __builtin_bit_cast(float, w << 16); }
__device__ __forceinline__ float bf_hi(unsigned w) { return __builtin_bit_cast(float, w & 0xffff0000u); }
__device__ __forceinline__ float wave_sum(float v) {
#pragma unroll
    for (int o = 1; o < 64; o <<= 1) v += __shfl_xor(v, o);
    return v;
}

__device__ __forceinline__ void p0_transpose_item(const float* W, int K, int N, bf16_t* WT, const float* gain, LAS float* scr, int item, int lane) {
    const int nblk = N / 32, kb = item / nblk, nb = item % nblk, k0 = 64 * kb, n0 = 32 * nb;
    float wv[32];
#pragma unroll
    for (int i = 0; i < 32; ++i) { const int kk = 2 * i + (lane >> 5); wv[i] = W[(size_t)(k0 + kk) * N + n0 + (lane & 31)]; }
#pragma unroll
    for (int i = 0; i < 32; ++i) { const int kk = 2 * i + (lane >> 5); const float g = gain ? gain[k0 + kk] : 1.0f; scr[kk * 33 + (lane & 31)] = wv[i] * g; }
    asm volatile("s_waitcnt lgkmcnt(0)" ::: "memory");
    const int c = lane & 7;
#pragma unroll
    for (int j = 0; j < 4; ++j) { const int n = (lane >> 3) + 8 * j; const LAS float* s = scr + (8 * c) * 33 + n;
        u32x4 o; o.x = pk2(s[0 * 33], s[1 * 33]); o.y = pk2(s[2 * 33], s[3 * 33]); o.z = pk2(s[4 * 33], s[5 * 33]); o.w = pk2(s[6 * 33], s[7 * 33]);
        *(u32x4*)(WT + (size_t)(n0 + n) * K + k0 + 8 * c) = o; }
    asm volatile("s_waitcnt lgkmcnt(0)" ::: "memory");
}

struct Args { const float* in[17]; float* out; unsigned char* ws; int ph_lo, ph_hi; };
typedef const __attribute__((address_space(4))) Args* ArgsP;
__device__ __forceinline__ ArgsP kargs() {
    const unsigned long long p = (unsigned long long)__builtin_amdgcn_kernarg_segment_ptr();
    unsigned lo = (unsigned)p, hi = (unsigned)(p >> 32);
    asm volatile("" : "+s"(lo), "+s"(hi));
    lo = __builtin_amdgcn_readfirstlane(lo); hi = __builtin_amdgcn_readfirstlane(hi);
    return (ArgsP)(((unsigned long long)hi << 32) | lo);
}
#define KA (kargs())
#define PHASE_IDS() int tid_ = threadIdx.x; asm volatile("" : "+v"(tid_)); const int tid = tid_, lane = tid & 63, wave = __builtin_amdgcn_readfirstlane(tid >> 6); \
    int bx_ = blockIdx.x; asm volatile("" : "+s"(bx_)); bx_ = __builtin_amdgcn_readfirstlane(bx_); int Gn_ = gridDim.x; asm volatile("" : "+s"(Gn_)); Gn_ = __builtin_amdgcn_readfirstlane(Gn_); const int vcu_ = (Gn_ % 8 == 0) ? (bx_ % 8) * (Gn_ / 8) + bx_ / 8 : bx_; const int gw = vcu_ * NWAVES + wave, ngw = Gn_ * NWAVES; (void)tid; (void)lane; (void)gw; (void)ngw

__device__ __forceinline__ void p0_prologue(LAS unsigned char* lds) {
    PHASE_IDS();
    LAS float* scr = (LAS float*)(lds + wave * 16384);
    ArgsP ap = KA; unsigned char* ws = ap->ws;
    constexpr int I_W1 = 16 * 128, I_W2 = 64 * 32, I_QKV = 16 * 96, I_WO = 16 * 32, I_WIN = 16 * 64;
    constexpr int NITEMS = 4 * I_W1 + 4 * I_W2 + 2 * I_QKV + 2 * I_WO + 2 * I_WIN + 2 * I_WO;
    for (int it = gw; it < NITEMS; it += ngw) {
        int r = it;
        if (r < 4 * I_W1) { const int l = r / I_W1; p0_transpose_item(ap->in[3] + (size_t)l * DM * FF, DM, FF, (bf16_t*)(ws + WS_W1) + (size_t)l * DM * FF, ap->in[2] + l * DM, scr, r % I_W1, lane); continue; } r -= 4 * I_W1;
        if (r < 4 * I_W2) { const int l = r / I_W2; p0_transpose_item(ap->in[4] + (size_t)l * DM * FF, FF, DM, (bf16_t*)(ws + WS_W2) + (size_t)l * DM * FF, nullptr, scr, r % I_W2, lane); continue; } r -= 4 * I_W2;
        if (r < 2 * I_QKV) { const int l = r / I_QKV; p0_transpose_item(ap->in[5] + (size_t)l * DM * 3 * DM, DM, 3 * DM, (bf16_t*)(ws + WS_WQKV) + (size_t)l * DM * 3 * DM, ap->in[1] + (2 * l) * DM, scr, r % I_QKV, lane); continue; } r -= 2 * I_QKV;
        if (r < 2 * I_WO) { const int l = r / I_WO; p0_transpose_item(ap->in[6] + (size_t)l * DM * DM, DM, DM, (bf16_t*)(ws + WS_WO) + (size_t)l * DM * DM, nullptr, scr, r % I_WO, lane); continue; } r -= 2 * I_WO;
        if (r < 2 * I_WIN) { const int l = r / I_WIN; p0_transpose_item(ap->in[7] + (size_t)l * DM * 2 * DM, DM, 2 * DM, (bf16_t*)(ws + WS_WIN) + (size_t)l * DM * 2 * DM, ap->in[1] + (2 * l + 1) * DM, scr, r % I_WIN, lane); continue; } r -= 2 * I_WIN;
        { const int l = r / I_WO; p0_transpose_item(ap->in[15] + (size_t)l * DM * DM, DM, DM, (bf16_t*)(ws + WS_WRO) + (size_t)l * DM * DM, nullptr, scr, r % I_WO, lane); }
    }
    const float* x = ap->in[0]; bf16_t* xb = (bf16_t*)(ws + WS_XB); float* ssq = (float*)(ws + WS_SSQ);
    for (int m0 = gw * 4; m0 < M; m0 += ngw * 4) {
        f32x4 v[4][4];
#pragma unroll
        for (int r = 0; r < 4; ++r)
#pragma unroll
            for (int j = 0; j < 4; ++j) v[r][j] = ((const f32x4*)(x + (size_t)(m0 + r) * DM) + lane)[64 * j];
#pragma unroll
        for (int r = 0; r < 4; ++r) {
            u32x2* o8 = (u32x2*)(xb + (size_t)(m0 + r) * DM) + lane; float s = 0.f;
#pragma unroll
            for (int j = 0; j < 4; ++j) { const f32x4 t = v[r][j]; s += (t.x * t.x + t.y * t.y) + (t.z * t.z + t.w * t.w); u32x2 w; w.x = pk2(t.x, t.y); w.y = pk2(t.z, t.w); o8[64 * j] = w; }
            s = wave_sum(s);
            if (lane < 16) ssq[(size_t)(m0 + r) * 16 + lane] = (lane == 0) ? s : 0.f;
        }
    }
}

__device__ __forceinline__ void final_norm(float* out, const bf16_t* xb, const float* ssq, const float* g) {
    PHASE_IDS();
    f32x4 gg[4];
#pragma unroll
    for (int j = 0; j < 4; ++j) gg[j] = ((const f32x4*)g + lane)[64 * j];
    for (int m0 = gw * 4; m0 < M; m0 += ngw * 4) {
        u32x2 w[4][4]; float rs[4];
#pragma unroll
        for (int r = 0; r < 4; ++r) {
#pragma unroll
            for (int j = 0; j < 4; ++j) w[r][j] = ((const u32x2*)(xb + (size_t)(m0 + r) * DM) + lane)[64 * j];
            rs[r] = pg8::row_rstd(ssq, m0 + r);
        }
#pragma unroll
        for (int r = 0; r < 4; ++r) {
            f32x4* orow = (f32x4*)(out + (size_t)(m0 + r) * DM) + lane;
#pragma unroll
            for (int j = 0; j < 4; ++j) { const f32x4 v = {bf_lo(w[r][j].x), bf_hi(w[r][j].x), bf_lo(w[r][j].y), bf_hi(w[r][j].y)}; __builtin_nontemporal_store(v * rs[r] * gg[j], &orow[64 * j]); }
        }
    }
}

__device__ __forceinline__ int crow(int r, int hi) { return (r & 3) + 8 * (r >> 2) + 4 * hi; }
constexpr int VPITCH = 144;
template <bool DIAG> __device__ __forceinline__ void att_elem(const f32x16& s, float& P, int j, int hi, bf16x8& pb0, bf16x8& pb1) {
    float w[16], T[4];
#pragma unroll
    for (int g = 0; g < 4; ++g) {
        float bt[4], kp[4];
#pragma unroll
        for (int e = 0; e < 4; ++e) {
            const int r = 4 * g + e;
            float nz; asm("v_min_f32_e64 %0, -%1, %2" : "=v"(nz) : "v"(s[r]), "s"(100.0f));
            const float ex = __builtin_amdgcn_exp2f(nz);
            float be = __builtin_amdgcn_rcpf(1.0f + ex); float ke = ex * be;
            if (DIAG && !(crow(r, hi) < j)) { be = 0.f; ke = 1.f; }
            bt[e] = be; kp[e] = ke;
        }
        const float s2 = kp[3], s1 = s2 * kp[2], s0 = s1 * kp[1];
        w[4 * g + 3] = bt[3]; w[4 * g + 2] = bt[2] * s2; w[4 * g + 1] = bt[1] * s1; w[4 * g + 0] = bt[0] * s0; T[g] = s0 * kp[0];
    }
    float sp3 = P, U[4], pr[4];
#pragma unroll
    for (int g = 0; g < 4; ++g) { U[g] = __shfl_xor(T[g], 32); pr[g] = T[g] * U[g]; }
    const float sp2 = sp3 * pr[3], sp1 = sp2 * pr[2], sp0 = sp1 * pr[1];
    P = sp0 * pr[0];
    { const float m3 = sp3 * (hi ? 1.0f : U[3]), m2 = sp2 * (hi ? 1.0f : U[2]), m1 = sp1 * (hi ? 1.0f : U[1]), m0 = sp0 * (hi ? 1.0f : U[0]);
#pragma unroll
      for (int e = 0; e < 4; ++e) { w[e] *= m0; w[4 + e] *= m1; w[8 + e] *= m2; w[12 + e] *= m3; } }
    u32x4 p0, p1;
    p0.x = pg8::cvt_pk_bf16(w[0], w[1]); p0.y = pg8::cvt_pk_bf16(w[2], w[3]); p0.z = pg8::cvt_pk_bf16(w[4], w[5]); p0.w = pg8::cvt_pk_bf16(w[6], w[7]);
    p1.x = pg8::cvt_pk_bf16(w[8], w[9]); p1.y = pg8::cvt_pk_bf16(w[10], w[11]); p1.z = pg8::cvt_pk_bf16(w[12], w[13]); p1.w = pg8::cvt_pk_bf16(w[14], w[15]);
    pb0 = __builtin_bit_cast(bf16x8, p0); pb1 = __builtin_bit_cast(bf16x8, p1);
}
__device__ __forceinline__ void attn_phase(LAS unsigned char* lds, const bf16_t* __restrict__ Q, const bf16_t* __restrict__ K, const bf16_t* __restrict__ V, bf16_t* __restrict__ O) {
    PHASE_IDS();
    LAS unsigned char* vl = lds + wave * (32 * VPITCH);
    const int j = lane & 31, hi = lane >> 5;
    const int g16 = lane >> 4, dsel = g16 & 1, qq = (lane & 15) >> 2, pp = lane & 3;
    const LAS unsigned char* vrd = vl + (4 * hi + qq) * VPITCH + (16 * dsel + 4 * pp) * 2;
#define VTR(off) __builtin_amdgcn_ds_read_tr16_b64_v4i16((LAS v4i16_t*)(vrd + (off)))
#define VFRAG(db, ks) ({ const v4i16_t lo_ = VTR((16 * (ks)) * VPITCH + (db) * 64), hi_ = VTR((16 * (ks) + 8) * VPITCH + (db) * 64); (bf16x8){lo_[0], lo_[1], lo_[2], lo_[3], hi_[0], hi_[1], hi_[2], hi_[3]}; })
#define ATT_LOADKV(KT) do { const bf16_t* Kp = K + (rowb + (KT) * 32 + j) * DM + h * 64 + hi * 8; \
            _Pragma("unroll") for (int d0 = 0; d0 < 4; ++d0) kf[d0] = *(const bf16x8*)(Kp + d0 * 16); \
            _Pragma("unroll") for (int i = 0; i < 4; ++i) { const int c = lane + 64 * i; vst[i] = *(const u32x4*)(V + (rowb + (KT) * 32 + (c >> 3)) * DM + h * 64 + (c & 7) * 8); } } while (0)
#define ATT_STAGEV() do { _Pragma("unroll") for (int i = 0; i < 4; ++i) { const int c = lane + 64 * i; *(LAS u32x4*)(vl + (c >> 3) * VPITCH + (c & 7) * 16) = vst[i]; } } while (0)
#define ATT_QK(S, QF) do { S = (f32x16){}; _Pragma("unroll") for (int d0 = 0; d0 < 4; ++d0) S = __builtin_amdgcn_mfma_f32_32x32x16_bf16(kf[d0], QF[d0], S, 0, 0, 0); } while (0)
#define ATT_PV(OA, OB, PB0, PB1) do { OA = __builtin_amdgcn_mfma_f32_32x32x16_bf16(v00, PB0, OA, 0, 0, 0); OA = __builtin_amdgcn_mfma_f32_32x32x16_bf16(v01, PB1, OA, 0, 0, 0); \
            OB = __builtin_amdgcn_mfma_f32_32x32x16_bf16(v10, PB0, OB, 0, 0, 0); OB = __builtin_amdgcn_mfma_f32_32x32x16_bf16(v11, PB1, OB, 0, 0, 0); } while (0)
#define ATT_ALIVE(P) (__builtin_amdgcn_ballot_w64((P) >= 1.17549435e-38f) != 0ull)
    for (int unit = gw; unit < BATCH * NHEAD * (SEQ / 64); unit += ngw) {
        const int qp = unit & 31, bh = unit >> 5, b = bh >> 4, h = bh & 15;
        const size_t rowb = (size_t)b * SEQ; const int q0 = qp * 64;
        bf16x8 qfa[4], qfb[4];
        { const bf16_t* Qp = Q + (rowb + q0 + j) * DM + h * 64 + hi * 8;
#pragma unroll
          for (int d0 = 0; d0 < 4; ++d0) { qfa[d0] = *(const bf16x8*)(Qp + d0 * 16); qfb[d0] = *(const bf16x8*)(Qp + 32 * DM + d0 * 16); } }
        f32x16 oa0 = {}, oa1 = {}, ob0 = {}, ob1 = {}; float Pa = 1.0f, Pb = 1.0f;
        bf16x8 kf[4]; u32x4 vst[4];
        const int top = 2 * qp + 1;
        { ATT_LOADKV(top); f32x16 sb; ATT_QK(sb, qfb); ATT_STAGEV(); asm volatile("s_nop 15\n\ts_nop 7" : "+v"(sb));
          bf16x8 pb0, pb1; att_elem<true>(sb, Pb, j, hi, pb0, pb1);
          asm volatile("s_waitcnt lgkmcnt(0)" ::: "memory");
          const bf16x8 v00 = VFRAG(0, 0), v01 = VFRAG(0, 1), v10 = VFRAG(1, 0), v11 = VFRAG(1, 1); ATT_PV(ob0, ob1, pb0, pb1);
          asm volatile("s_waitcnt lgkmcnt(0)" ::: "memory"); }
        { ATT_LOADKV(top - 1); f32x16 sa, sb; ATT_QK(sa, qfa); ATT_QK(sb, qfb); ATT_STAGEV(); asm volatile("s_nop 15\n\ts_nop 7" : "+v"(sa), "+v"(sb));
          bf16x8 pa0, pa1, pb0, pb1; att_elem<true>(sa, Pa, j, hi, pa0, pa1); att_elem<false>(sb, Pb, j, hi, pb0, pb1);
          asm volatile("s_waitcnt lgkmcnt(0)" ::: "memory");
          const bf16x8 v00 = VFRAG(0, 0), v01 = VFRAG(0, 1), v10 = VFRAG(1, 0), v11 = VFRAG(1, 1); ATT_PV(oa0, oa1, pa0, pa1); ATT_PV(ob0, ob1, pb0, pb1);
          asm volatile("s_waitcnt lgkmcnt(0)" ::: "memory"); }
        bool alive_a = ATT_ALIVE(Pa), alive_b = ATT_ALIVE(Pb);
        for (int kt = top - 2; kt >= 0 && (alive_a || alive_b); --kt) {
            ATT_LOADKV(kt);
            if (alive_a && alive_b) {
                f32x16 sa, sb; ATT_QK(sa, qfa); ATT_QK(sb, qfb); ATT_STAGEV(); asm volatile("s_nop 15\n\ts_nop 7" : "+v"(sa), "+v"(sb));
                bf16x8 pa0, pa1, pb0, pb1; att_elem<false>(sa, Pa, j, hi, pa0, pa1); att_elem<false>(sb, Pb, j, hi, pb0, pb1);
                asm volatile("s_waitcnt lgkmcnt(0)" ::: "memory");
                const bf16x8 v00 = VFRAG(0, 0), v01 = VFRAG(0, 1), v10 = VFRAG(1, 0), v11 = VFRAG(1, 1); ATT_PV(oa0, oa1, pa0, pa1); ATT_PV(ob0, ob1, pb0, pb1);
                alive_a = ATT_ALIVE(Pa); alive_b = ATT_ALIVE(Pb);
            } else if (alive_a) {
                f32x16 sa; ATT_QK(sa, qfa); ATT_STAGEV(); asm volatile("s_nop 15\n\ts_nop 7" : "+v"(sa));
                bf16x8 pa0, pa1; att_elem<false>(sa, Pa, j, hi, pa0, pa1);
                asm volatile("s_waitcnt lgkmcnt(0)" ::: "memory");
                const bf16x8 v00 = VFRAG(0, 0), v01 = VFRAG(0, 1), v10 = VFRAG(1, 0), v11 = VFRAG(1, 1); ATT_PV(oa0, oa1, pa0, pa1);
                alive_a = ATT_ALIVE(Pa);
            } else {
                f32x16 sb; ATT_QK(sb, qfb); ATT_STAGEV(); asm volatile("s_nop 15\n\ts_nop 7" : "+v"(sb));
                bf16x8 pb0, pb1; att_elem<false>(sb, Pb, j, hi, pb0, pb1);
                asm volatile("s_waitcnt lgkmcnt(0)" ::: "memory");
                const bf16x8 v00 = VFRAG(0, 0), v01 = VFRAG(0, 1), v10 = VFRAG(1, 0), v11 = VFRAG(1, 1); ATT_PV(ob0, ob1, pb0, pb1);
                alive_b = ATT_ALIVE(Pb);
            }
            asm volatile("s_waitcnt lgkmcnt(0)" ::: "memory");
        }
        bf16_t* Op = O + (rowb + q0 + j) * DM + h * 64 + 4 * hi;
#pragma unroll
        for (int g = 0; g < 4; ++g) {
            u32x2 a, c; a.x = pg8::cvt_pk_bf16(oa0[4 * g], oa0[4 * g + 1]); a.y = pg8::cvt_pk_bf16(oa0[4 * g + 2], oa0[4 * g + 3]);
            c.x = pg8::cvt_pk_bf16(oa1[4 * g], oa1[4 * g + 1]); c.y = pg8::cvt_pk_bf16(oa1[4 * g + 2], oa1[4 * g + 3]);
            *(u32x2*)(Op + 8 * g) = a; *(u32x2*)(Op + 32 + 8 * g) = c;
            a.x = pg8::cvt_pk_bf16(ob0[4 * g], ob0[4 * g + 1]); a.y = pg8::cvt_pk_bf16(ob0[4 * g + 2], ob0[4 * g + 3]);
            c.x = pg8::cvt_pk_bf16(ob1[4 * g], ob1[4 * g + 1]); c.y = pg8::cvt_pk_bf16(ob1[4 * g + 2], ob1[4 * g + 3]);
            *(u32x2*)(Op + 32 * DM + 8 * g) = a; *(u32x2*)(Op + 32 * DM + 32 + 8 * g) = c;
        }
    }
#undef VTR
#undef VFRAG
#undef ATT_LOADKV
#undef ATT_STAGEV
#undef ATT_QK
#undef ATT_PV
#undef ATT_ALIVE
}

constexpr int RG_WF = 0, RG_CONST = 16384, RG_TOT = RG_CONST + 8 * 64 * 4, RG_LDS_END = RG_TOT + 2 * 8 * 64 * 8;
template <int CTRL> __device__ __forceinline__ float dpp_f(float old, float src) {
    return __builtin_bit_cast(float, __builtin_amdgcn_update_dpp(__builtin_bit_cast(int, old), __builtin_bit_cast(int, src), CTRL, 0xf, 0xf, false));
}
__device__ __forceinline__ float sigmoid_f(float x) { const float e = __builtin_amdgcn_exp2f(-fminf(fmaxf(x, -80.f), 80.f) * 1.4426950408889634f); return __builtin_amdgcn_rcpf(1.0f + e); }
__device__ __forceinline__ void rg_phase(LAS unsigned char* lds, int li) {
    PHASE_IDS();
    const int tl = lane & 15, kg = lane >> 4;
    for (int unit = blockIdx.x; unit < BATCH * 16; unit += gridDim.x) {
        const int b = unit >> 4, hb = unit & 15;
        __syncthreads();
        for (int f = tid; f < 2 * 4 * 2 * 64; f += 512) {
            const int ln = f & 63, ks = (f >> 6) & 1, jb = (f >> 7) & 3, mat = f >> 9; const int jr = ln & 15, kgg = ln >> 4;
            const float* Wm = (mat ? KA->in[12] : KA->in[10]) + (size_t)li * 16 * 4096 + (size_t)hb * 4096;
            float v[8];
#pragma unroll
            for (int e = 0; e < 8; ++e) v[e] = Wm[(16 * (2 * ks + (e >> 2)) + 4 * kgg + (e & 3)) * 64 + 16 * jb + jr];
            u32x4 o; o.x = pk2(v[0], v[1]); o.y = pk2(v[2], v[3]); o.z = pk2(v[4], v[5]); o.w = pk2(v[6], v[7]);
            *(LAS u32x4*)(lds + RG_WF + f * 16) = o;
        }
        for (int c = tid; c < 8 * 64; c += 512) {
            const int k = c >> 6, ch = hb * 64 + (c & 63); float v;
            if (k < 4) v = (KA->in[8] + li * 4 * DM)[k * 1024 + ch]; else if (k == 4) v = (KA->in[9] + li * DM)[ch]; else if (k == 5) v = -1.4426950408889634f * (KA->in[11] + li * DM)[ch]; else if (k == 6) v = -1.4426950408889634f * (KA->in[13] + li * DM)[ch];
            else { const float l = (KA->in[14] + li * DM)[ch]; const float y = __builtin_amdgcn_exp2f(-fabsf(l) * 1.4426950408889634f);
                   const float l1p = (y < 0.03f) ? y * (1.0f - y * (0.5f - y * (0.33333334f - y * 0.25f))) : __builtin_amdgcn_logf(1.0f + y) * 0.6931471805599453f;
                   v = -16.0f * (fmaxf(-l, 0.f) + l1p); }
            ((LAS float*)(lds + RG_CONST))[c] = v;
        }
        __syncthreads();
        float hc[16];
#pragma unroll
        for (int i = 0; i < 16; ++i) hc[i] = 0.f;
        const size_t rowb = (size_t)b * SEQ; const int cbase = hb * 64 + 4 * kg;
        const bf16_t* __restrict__ G = (const bf16_t*)(KA->ws + WS_BIG); const bf16_t* __restrict__ XP = G + (size_t)M * DM; bf16_t* __restrict__ Y = (bf16_t*)(KA->ws + WS_BIG) + 2 * (size_t)M * DM;
#define RG_LOAD(chunk_, XPA, GVA) do { const int t_ = (chunk_) * 128 + wave * 16 + tl; \
            _Pragma("unroll") for (int tap = 0; tap < 4; ++tap) { const int ts = t_ - 3 + tap; const bf16_t* xr = XP + (rowb + (ts > 0 ? ts : 0)) * DM + cbase; \
                _Pragma("unroll") for (int jb = 0; jb < 4; ++jb) XPA[tap][jb] = *(const u32x2*)(xr + 16 * jb); } \
            if ((chunk_) == 0 && wave == 0) { _Pragma("unroll") for (int tap = 0; tap < 3; ++tap) if (t_ - 3 + tap < 0) { _Pragma("unroll") for (int jb = 0; jb < 4; ++jb) XPA[tap][jb] = (u32x2){0u, 0u}; } } \
            _Pragma("unroll") for (int jb = 0; jb < 4; ++jb) GVA[jb] = *(const u32x2*)(G + (rowb + t_) * DM + cbase + 16 * jb); } while (0)
        u32x2 xpn[4][4], gvn[4];
        RG_LOAD(0, xpn, gvn);
        for (int chunk = 0; chunk < SEQ / 128; ++chunk) {
            const int t = chunk * 128 + wave * 16 + tl;
            float xc[16];
#pragma unroll
            for (int jb = 0; jb < 4; ++jb) {
                const f32x4 cb = *(const LAS f32x4*)(lds + RG_CONST + (4 * 64 + 16 * jb + 4 * kg) * 4);
                xc[4 * jb] = cb.x; xc[4 * jb + 1] = cb.y; xc[4 * jb + 2] = cb.z; xc[4 * jb + 3] = cb.w;
            }
#pragma unroll
            for (int tap = 0; tap < 4; ++tap) {
#pragma unroll
                for (int jb = 0; jb < 4; ++jb) {
                    const u32x2 xv = xpn[tap][jb];
                    const f32x4 cw = *(const LAS f32x4*)(lds + RG_CONST + (tap * 64 + 16 * jb + 4 * kg) * 4);
                    xc[4 * jb] += cw.x * bf_lo(xv.x); xc[4 * jb + 1] += cw.y * bf_hi(xv.x); xc[4 * jb + 2] += cw.z * bf_lo(xv.y); xc[4 * jb + 3] += cw.w * bf_hi(xv.y);
                }
            }
            u32x2 gv[4];
#pragma unroll
            for (int jb = 0; jb < 4; ++jb) gv[jb] = gvn[jb];
            { const int cn = (chunk + 1 < SEQ / 128) ? chunk + 1 : chunk; RG_LOAD(cn, xpn, gvn); }
            u32x4 xb0, xb1;
            xb0.x = pg8::cvt_pk_bf16(xc[0], xc[1]); xb0.y = pg8::cvt_pk_bf16(xc[2], xc[3]); xb0.z = pg8::cvt_pk_bf16(xc[4], xc[5]); xb0.w = pg8::cvt_pk_bf16(xc[6], xc[7]);
            xb1.x = pg8::cvt_pk_bf16(xc[8], xc[9]); xb1.y = pg8::cvt_pk_bf16(xc[10], xc[11]); xb1.z = pg8::cvt_pk_bf16(xc[12], xc[13]); xb1.w = pg8::cvt_pk_bf16(xc[14], xc[15]);
            const bf16x8 bx0 = __builtin_bit_cast(bf16x8, xb0), bx1 = __builtin_bit_cast(bf16x8, xb1);
            float av[16], bv[16];
#pragma unroll
            for (int jb = 0; jb < 4; ++jb) {
                f32x4 ra = {0.f, 0.f, 0.f, 0.f}, ri = {0.f, 0.f, 0.f, 0.f};
                const bf16x8 wa0 = *(const LAS bf16x8*)(lds + RG_WF + (((0 * 4 + jb) * 2 + 0) * 64 + lane) * 16), wa1 = *(const LAS bf16x8*)(lds + RG_WF + (((0 * 4 + jb) * 2 + 1) * 64 + lane) * 16);
                const bf16x8 wx0 = *(const LAS bf16x8*)(lds + RG_WF + (((1 * 4 + jb) * 2 + 0) * 64 + lane) * 16), wx1 = *(const LAS bf16x8*)(lds + RG_WF + (((1 * 4 + jb) * 2 + 1) * 64 + lane) * 16);
                ra = __builtin_amdgcn_mfma_f32_16x16x32_bf16(wa0, bx0, ra, 0, 0, 0); ra = __builtin_amdgcn_mfma_f32_16x16x32_bf16(wa1, bx1, ra, 0, 0, 0);
                ri = __builtin_amdgcn_mfma_f32_16x16x32_bf16(wx0, bx0, ri, 0, 0, 0); ri = __builtin_amdgcn_mfma_f32_16x16x32_bf16(wx1, bx1, ri, 0, 0, 0);
                const f32x4 ba = *(const LAS f32x4*)(lds + RG_CONST + (5 * 64 + 16 * jb + 4 * kg) * 4), bxx = *(const LAS f32x4*)(lds + RG_CONST + (6 * 64 + 16 * jb + 4 * kg) * 4);
                const f32x4 lu = *(const LAS f32x4*)(lds + RG_CONST + (7 * 64 + 16 * jb + 4 * kg) * 4);
#pragma unroll
                for (int r = 0; r < 4; ++r) {
                    const float rg = __builtin_amdgcn_rcpf(1.0f + __builtin_amdgcn_exp2f(__builtin_fmaf(ra[r], -1.4426950408889634f, ba[r])));
                    const float ig = __builtin_amdgcn_rcpf(1.0f + __builtin_amdgcn_exp2f(__builtin_fmaf(ri[r], -1.4426950408889634f, bxx[r])));
                    const float x2 = rg * lu[r];
                    const float a = __builtin_amdgcn_exp2f(x2 * 0.7213475204444817f);
                    const float ser = -x2 * (1.0f + x2 * (0.5f + x2 * (0.16666667f + x2 * (0.041666668f + x2 * 0.008333334f))));
                    const float m2 = (x2 > -0.25f) ? ser : (1.0f - a * a);
                    av[4 * jb + r] = a; bv[4 * jb + r] = __builtin_amdgcn_sqrtf(fmaxf(m2, 0.f)) * (ig * xc[4 * jb + r]);
                }
            }
#define RG_SCAN8(N, A0, A1, A2, A3, A4, A5, A6, A7, B0, B1, B2, B3, B4, B5, B6, B7) asm volatile("s_nop 1\n\t" \
                "v_fmac_f32_dpp %8, %8, %0 row_shr:" #N " row_mask:0xf bank_mask:0xf\n\t" "v_fmac_f32_dpp %9, %9, %1 row_shr:" #N " row_mask:0xf bank_mask:0xf\n\t" \
                "v_fmac_f32_dpp %10, %10, %2 row_shr:" #N " row_mask:0xf bank_mask:0xf\n\t" "v_fmac_f32_dpp %11, %11, %3 row_shr:" #N " row_mask:0xf bank_mask:0xf\n\t" \
                "v_fmac_f32_dpp %12, %12, %4 row_shr:" #N " row_mask:0xf bank_mask:0xf\n\t" "v_fmac_f32_dpp %13, %13, %5 row_shr:" #N " row_mask:0xf bank_mask:0xf\n\t" \
                "v_fmac_f32_dpp %14, %14, %6 row_shr:" #N " row_mask:0xf bank_mask:0xf\n\t" "v_fmac_f32_dpp %15, %15, %7 row_shr:" #N " row_mask:0xf bank_mask:0xf\n\t" \
                "v_mul_f32_dpp %0, %0, %0 row_shr:" #N " row_mask:0xf bank_mask:0xf\n\t" "v_mul_f32_dpp %1, %1, %1 row_shr:" #N " row_mask:0xf bank_mask:0xf\n\t" \
                "v_mul_f32_dpp %2, %2, %2 row_shr:" #N " row_mask:0xf bank_mask:0xf\n\t" "v_mul_f32_dpp %3, %3, %3 row_shr:" #N " row_mask:0xf bank_mask:0xf\n\t" \
                "v_mul_f32_dpp %4, %4, %4 row_shr:" #N " row_mask:0xf bank_mask:0xf\n\t" "v_mul_f32_dpp %5, %5, %5 row_shr:" #N " row_mask:0xf bank_mask:0xf\n\t" \
                "v_mul_f32_dpp %6, %6, %6 row_shr:" #N " row_mask:0xf bank_mask:0xf\n\t" "v_mul_f32_dpp %7, %7, %7 row_shr:" #N " row_mask:0xf bank_mask:0xf" \
                : "+v"(A0), "+v"(A1), "+v"(A2), "+v"(A3), "+v"(A4), "+v"(A5), "+v"(A6), "+v"(A7), "+v"(B0), "+v"(B1), "+v"(B2), "+v"(B3), "+v"(B4), "+v"(B5), "+v"(B6), "+v"(B7))
#define RG_SCAN_ALL(N) do { RG_SCAN8(N, av[0], av[1], av[2], av[3], av[4], av[5], av[6], av[7], bv[0], bv[1], bv[2], bv[3], bv[4], bv[5], bv[6], bv[7]); \
                            RG_SCAN8(N, av[8], av[9], av[10], av[11], av[12], av[13], av[14], av[15], bv[8], bv[9], bv[10], bv[11], bv[12], bv[13], bv[14], bv[15]); } while (0)
            RG_SCAN_ALL(1); RG_SCAN_ALL(2); RG_SCAN_ALL(4); RG_SCAN_ALL(8);
#undef RG_SCAN_ALL
#undef RG_SCAN8
            LAS f32x2* tot = (LAS f32x2*)(lds + RG_TOT + (chunk & 1) * (8 * 64 * 8));
            if (tl == 15) {
#pragma unroll
                for (int jb = 0; jb < 4; ++jb)
#pragma unroll
                    for (int r = 0; r < 4; ++r) tot[wave * 64 + 16 * jb + 4 * kg + r] = (f32x2){av[4 * jb + r], bv[4 * jb + r]};
            }
            asm volatile("s_waitcnt lgkmcnt(0)" ::: "memory"); __builtin_amdgcn_s_barrier(); asm volatile("" ::: "memory");
#pragma unroll 1
            for (int w2 = 0; w2 < wave; ++w2) {
#pragma unroll
                for (int jb = 0; jb < 4; ++jb)
#pragma unroll
                    for (int r = 0; r < 4; ++r) { const f32x2 ab = tot[w2 * 64 + 16 * jb + 4 * kg + r]; hc[4 * jb + r] = ab.x * hc[4 * jb + r] + ab.y; }
            }
            float hin[16];
#pragma unroll
            for (int i = 0; i < 16; ++i) hin[i] = hc[i];
#pragma unroll 1
            for (int w2 = wave; w2 < 8; ++w2) {
#pragma unroll
                for (int jb = 0; jb < 4; ++jb)
#pragma unroll
                    for (int r = 0; r < 4; ++r) { const f32x2 ab = tot[w2 * 64 + 16 * jb + 4 * kg + r]; hc[4 * jb + r] = ab.x * hc[4 * jb + r] + ab.y; }
            }
            bf16_t* yr = Y + (rowb + t) * DM + cbase;
#pragma unroll
            for (int jb = 0; jb < 4; ++jb) {
                const float h0 = av[4 * jb] * hin[4 * jb] + bv[4 * jb], h1 = av[4 * jb + 1] * hin[4 * jb + 1] + bv[4 * jb + 1];
                const float h2 = av[4 * jb + 2] * hin[4 * jb + 2] + bv[4 * jb + 2], h3 = av[4 * jb + 3] * hin[4 * jb + 3] + bv[4 * jb + 3];
                u32x2 o; o.x = pg8::cvt_pk_bf16(h0 * bf_lo(gv[jb].x), h1 * bf_hi(gv[jb].x)); o.y = pg8::cvt_pk_bf16(h2 * bf_lo(gv[jb].y), h3 * bf_hi(gv[jb].y));
                *(u32x2*)(yr + 16 * jb) = o;
            }
        }
#undef RG_LOAD
    }
    __syncthreads();
}

template <int p> __device__ __forceinline__ void run_phase(LAS unsigned char* lds) {
    ArgsP ap = KA; unsigned char* ws = ap->ws;
    bf16_t* XB = (bf16_t*)(ws + WS_XB); float* SSQ = (float*)(ws + WS_SSQ); bf16_t* BIG = (bf16_t*)(ws + WS_BIG);
    const size_t MD = (size_t)M * DM;
    LAS float* RTAB = (LAS float*)(lds + 131072);
    int bx = blockIdx.x, Gn = gridDim.x; asm volatile("" : "+s"(bx), "+s"(Gn)); bx = __builtin_amdgcn_readfirstlane(bx); Gn = __builtin_amdgcn_readfirstlane(Gn);
    if constexpr (p == 0) { p0_prologue(lds); __syncthreads(); }
    else if constexpr (p == NPHASE - 1) { final_norm(ap->out, XB, SSQ, ap->in[16]); }
    else {
        constexpr int q = p - 1, layer = q / 5, k = q - 5 * layer, li = layer >> 1; constexpr bool even = (layer & 1) == 0;
        if constexpr (k == 0 || k == 3) {
            constexpr int N = (k == 3) ? FF : (even ? 3 * DM : 2 * DM), mode = (k == 3) ? 2 : (even ? 0 : 1), split = (k == 3) ? 0 : DM;
            const bf16_t* Bt = (k == 3) ? (const bf16_t*)(ws + WS_W1) + (size_t)layer * DM * FF : even ? (const bf16_t*)(ws + WS_WQKV) + (size_t)li * DM * 3 * DM : (const bf16_t*)(ws + WS_WIN) + (size_t)li * DM * 2 * DM;
            pg8::Gemm g{XB, Bt, M, N, DM}; pg8::FastOrder S; S.init(M, N, Gn, bx);
            pg8::fill_rstd(RTAB, SSQ, S);
            pg8::EpiAct E{BIG, split ? DM : FF, split, MD, RTAB, mode};
            pg8::gemm_phase<pg8::EpiAct, pg8::FastOrder, true, true>(lds, g, S, E);
        } else if constexpr (k == 2 || k == 4) {
            constexpr int K = (k == 4) ? FF : DM;
            const bf16_t* A = (k == 4) ? BIG : even ? BIG + 3 * MD : BIG + 2 * MD;
            const bf16_t* Bt = (k == 4) ? (const bf16_t*)(ws + WS_W2) + (size_t)layer * DM * FF : even ? (const bf16_t*)(ws + WS_WO) + (size_t)li * DM * DM : (const bf16_t*)(ws + WS_WRO) + (size_t)li * DM * DM;
            pg8::Gemm g{A, Bt, M, DM, K}; pg8::FastOrder S; S.init(M, DM, Gn, bx);
            pg8::EpiRes E{ws, WS_XB, WS_SSQ};
            pg8::gemm_phase<pg8::EpiRes, pg8::FastOrder, false, true>(lds, g, S, E);
        } else if constexpr (even) {
            attn_phase(lds, BIG, BIG + MD, BIG + 2 * MD, BIG + 3 * MD); __syncthreads();
        } else {
            rg_phase(lds, li);
        }
    }
}
constexpr int MISC_OFF = 131072 + 4096;
constexpr size_t WS_BAR = 0;
template <int p> __device__ __forceinline__ void run_from(LAS unsigned char* lds, cg::grid_group& grid) {
    if constexpr (p < NPHASE) {
        const int lo = KA->ph_lo, hi = KA->ph_hi;
        if (lo <= p && p < hi) {
#if defined(PROBE_DUP)
            if constexpr (p == PROBE_DUP) { for (int rep = 0; rep < PROBE_REPS; ++rep) { run_phase<p>(lds); grid.sync(); } }
#endif
            run_phase<p>(lds);
            if (p + 1 < hi) {
                if (hi > NPHASE) grid.sync();
                { XcdBarrier bar; bar.bar = (unsigned*)(KA->ws + WS_BAR); bar.x = xb_xcc_id(); bar.st = (volatile LAS unsigned*)(lds + MISC_OFF); xcd_barrier(bar); }
            }
        }
        run_from<p + 1>(lds, grid);
    }
}
__global__ void __launch_bounds__(NWAVES * 64, 2) hybrid_fwd(Args args_unused) {
    extern __shared__ __attribute__((aligned(16))) unsigned char lds_raw[];
    LAS unsigned char* lds = (LAS unsigned char*)lds_raw;
    cg::grid_group grid = cg::this_grid();
    if (threadIdx.x < 2) ((volatile LAS unsigned*)(lds + MISC_OFF))[threadIdx.x] = 0u;
    __syncthreads();
    if (KA->ph_hi - KA->ph_lo > 2) (void)xcd_barrier_post((unsigned*)(KA->ws + WS_BAR), (volatile LAS unsigned*)(lds + MISC_OFF));
    run_from<0>(lds, grid);
}

extern "C" void kernel_launch(void* const* d_in, const int* in_sizes, int n_in, void* d_out, int out_size, void* d_ws, size_t ws_size, hipStream_t stream) {
    static int grid = 0;
    if (grid == 0) {
        if (n_in != 17 || in_sizes[0] != M * DM || out_size != M * DM || ws_size < WS_END) { fprintf(stderr, "kernel_launch: unexpected shapes (n_in %d, in0 %d, out %d, ws %zu); nothing launched\n", n_in, n_in > 0 ? in_sizes[0] : -1, out_size, ws_size); grid = -1; return; }
        int dev = 0, cus = 0, per_cu = 0;
        if (hipGetDevice(&dev) != hipSuccess || hipDeviceGetAttribute(&cus, hipDeviceAttributeMultiprocessorCount, dev) != hipSuccess) { grid = -1; return; }
        if (hipFuncSetAttribute((const void*)hybrid_fwd, hipFuncAttributeMaxDynamicSharedMemorySize, LDS_BYTES) != hipSuccess) { fprintf(stderr, "kernel_launch: hipFuncSetAttribute failed\n"); grid = -1; return; }
        if (hipOccupancyMaxActiveBlocksPerMultiprocessor(&per_cu, (const void*)hybrid_fwd, NWAVES * 64, LDS_BYTES) != hipSuccess || per_cu < 1) { fprintf(stderr, "kernel_launch: occupancy query says %d\n", per_cu); per_cu = 1; }
        (void)hipGetLastError();
        grid = cus * per_cu;
    }
    if (grid < 0) return;
    Args a{};
    for (int i = 0; i < 17; ++i) a.in[i] = (const float*)d_in[i];
    a.out = (float*)d_out; a.ws = (unsigned char*)d_ws;
#if MK_ONE_LAUNCH
    a.ph_lo = 0; a.ph_hi = NPHASE;
    if (hipMemsetAsync((char*)d_ws + WS_BAR, 0, 16384, stream) != hipSuccess) { fprintf(stderr, "kernel_launch: hipMemsetAsync failed\n"); return; }
    { void* kargs[] = {&a}; hipError_t e = hipLaunchCooperativeKernel((const void*)hybrid_fwd, dim3(grid), dim3(NWAVES * 64), kargs, LDS_BYTES, stream);
      if (e != hipSuccess) fprintf(stderr, "cooperative launch failed: %s (grid %d)\n", hipGetErrorString(e), grid); }
#else
    for (int p = 0; p < NPHASE; ++p) {
        a.ph_lo = p; a.ph_hi = p + 1;
        void* kargs[] = {&a}; hipError_t e = hipLaunchCooperativeKernel((const void*)hybrid_fwd, dim3(grid), dim3(NWAVES * 64), kargs, LDS_BYTES, stream);
        if (e != hipSuccess) { fprintf(stderr, "launch %d failed: %s (grid %d)\n", p, hipGetErrorString(e), grid); break; }
    }
#endif
}
```

```cpp
#include <hip/hip_runtime.h>
#include <cstdio>
#include <cstdint>
#include <cmath>
namespace pg8 {
#define PG8_LAS __attribute__((address_space(3)))
typedef unsigned short bf16_t;
typedef short bf16x8 __attribute__((ext_vector_type(8)));
typedef float f32x4 __attribute__((ext_vector_type(4)));
typedef unsigned u32x4 __attribute__((ext_vector_type(4)));
constexpr int BM = 256, BK = 64, HALF = 128, HTB = HALF * BK * 2  , STAGE_BYTES = 8 * HTB, NXCD = 8, WGM = 8;

__host__ __device__ __forceinline__ int lds_byte(int r, int c) { const int st = (r >> 4) * 2 + (c >> 5), rr = r & 15, cc = c & 31, ob = rr * 64 + cc * 2; return st * 1024 + (ob ^ (((ob >> 9) & 1) << 5)); }
__host__ __device__ __forceinline__ void stage_rc(int b, int& R, int& C) { const int st = b / 1024, sb = b % 1024, swz = sb ^ (((sb >> 9) & 1) << 5); R = (st >> 1) * 16 + swz / 64; C = (st & 1) * 32 + (swz % 64) / 2; }
__host__ __device__ __forceinline__ int perm32(int rho) { const int n = rho >> 4, i = rho & 15; return 8 * (i >> 2) + 4 * n + (i & 3); }

struct Unit { int pm, pn; };
struct Gemm { const bf16_t* A; const bf16_t* Bt; int M, N, K; };

struct StaticOrder {
    int nM, nN, nwg, G, c;
    __host__ __device__ void init(int M, int N, int G_, int c_) { nM = M / BM; nN = N / BM; nwg = nM * nN; G = G_; c = c_; }
    __host__ __device__ bool next(int i, Unit& u) const {
        const long L = (long)i * G + c; if (L >= nwg) return false;
        int wgid = (int)L; { const int q = nwg / NXCD, r = nwg % NXCD, xcd = wgid % NXCD, off = wgid / NXCD; wgid = (xcd < r ? xcd * (q + 1) : r * (q + 1) + (xcd - r) * q) + off; }
        const int nig = WGM * nN, gid = wgid / nig, fm = gid * WGM, gsz = (nM - fm) < WGM ? (nM - fm) : WGM;
        u.pm = fm + ((wgid % nig) % gsz); u.pn = (wgid % nig) / gsz; return true;
    }
    __device__ __forceinline__ void a_ready(const Unit&) const {}
    __device__ __forceinline__ void done(const Unit&) const {}
};

__device__ __forceinline__ unsigned cvt_pk_bf16(float lo, float hi) { unsigned r; asm volatile("v_cvt_pk_bf16_f32 %0, %1, %2" : "=v"(r) : "v"(lo), "v"(hi)); return r; }
typedef unsigned u32x4 __attribute__((ext_vector_type(4)));
constexpr float RMS_EPS = 1e-6f;
constexpr float QSCALE = 0.125f * 1.4426950408889634f;
__device__ __forceinline__ float row_rstd(const float* ssq, int row) {
    const f32x4* sp = (const f32x4*)(ssq + (size_t)row * 16);
    const f32x4 a = sp[0], b = sp[1], c = sp[2], d = sp[3];
    const f32x4 s = (a + b) + (c + d);
    return __builtin_amdgcn_rsqf(((s.x + s.y) + (s.z + s.w)) * (1.0f / 1024.0f) + RMS_EPS);
}
__device__ __forceinline__ float gelu_tanh(float x) {
    const float u = x * (1.0f + 0.044715f * x * x) * (2.0f * 0.7978845608028654f * 1.4426950408889634f);
    const float e = __builtin_amdgcn_exp2f(-fminf(fmaxf(u, -100.f), 100.f));
    return x * __builtin_amdgcn_rcpf(1.0f + e);
}
template <class Sched> __device__ __forceinline__ void fill_rstd(PG8_LAS float* rtab, const float* ssq, const Sched& S) {
    int last0 = -1, last1 = -1; Unit u; int tx = threadIdx.x; asm volatile("" : "+v"(tx));
    for (int i = 0; S.next(i, u); ++i) {
        const int slot = (u.pm >> 3) & 1; const int last = slot ? last1 : last0;
        if (last != u.pm) { if (tx < 256) rtab[slot * 256 + tx] = row_rstd(ssq, u.pm * BM + tx); if (slot) last1 = u.pm; else last0 = u.pm; }
    }
    __syncthreads();
}

struct EpiAct {
    static constexpr bool PERM = true, AFTER_DRAIN = false;
    bf16_t* O; int ldc; int split_cols; size_t split_stride; const PG8_LAS float* rtab; int MODE; const float* ssq_fill;
    template <class Sched> __device__ __forceinline__ void prefill(const Sched& S) const { fill_rstd((PG8_LAS float*)rtab, ssq_fill, S); }
    __device__ __forceinline__ void operator()(const f32x4 (&acc)[2][2][4][2], const Unit& u, int wr, int wc, int fr, int fq) const {
        { int t2 = threadIdx.x; asm volatile("" : "+v"(t2)); fr = t2 & 15; fq = (t2 >> 4) & 3; }
        const int row0 = u.pm * BM + wr * 64 + fr; int colt = u.pn * BM; bf16_t* base = O; int t = 0;
        if (split_cols) { t = colt >> 10; base += (size_t)t * split_stride; colt &= 1023; }
        const int col0 = colt + wc * 32 + 8 * fq;
#pragma unroll
        for (int ai = 0; ai < 2; ++ai)
#pragma unroll
            for (int m = 0; m < 4; ++m) {
                const int row = row0 + ai * HALF + m * 16;
                float rs = rtab[((u.pm >> 3) & 1) * 256 + (row & 255)];
                if (MODE == 0 && t == 0) rs *= QSCALE;
                bf16_t* rowp = base + (size_t)row * ldc + col0;
#pragma unroll
                for (int bj = 0; bj < 2; ++bj) {
                    f32x4 v0 = acc[ai][bj][m][0] * rs, v1 = acc[ai][bj][m][1] * rs;
                    if (MODE == 1) { if (t == 0) {
#pragma unroll
                        for (int e = 0; e < 4; ++e) { v0[e] = gelu_tanh(v0[e]); v1[e] = gelu_tanh(v1[e]); } } }
                    if (MODE == 2) {
#pragma unroll
                        for (int e = 0; e < 4; ++e) { const float a = fmaxf(v0[e], 0.f), b = fmaxf(v1[e], 0.f); v0[e] = a * a; v1[e] = b * b; } }
                    u32x4 w; w.x = cvt_pk_bf16(v0[0], v0[1]); w.y = cvt_pk_bf16(v0[2], v0[3]); w.z = cvt_pk_bf16(v1[0], v1[1]); w.w = cvt_pk_bf16(v1[2], v1[3]);
                    *(u32x4*)(rowp + bj * HALF) = w;
                }
            }
    }
};
struct EpiRes {
    static constexpr bool PERM = true, AFTER_DRAIN = false;
    unsigned char* wsb; size_t xb_off, ssq_off;
    template <class Sched> __device__ __forceinline__ void prefill(const Sched&) const {}
    __device__ __forceinline__ void operator()(const f32x4 (&acc)[2][2][4][2], const Unit& u, int wr, int wc, int fr, int fq) const {
        { int t2 = threadIdx.x; asm volatile("" : "+v"(t2)); fr = t2 & 15; fq = (t2 >> 4) & 3; }
        bf16_t* xb = (bf16_t*)(wsb + xb_off); float* ssq = (float*)(wsb + ssq_off);
        const int row0 = u.pm * BM + wr * 64 + fr; const int col0 = u.pn * BM + wc * 32 + 8 * fq;
        u32x4 pre[2][4][2];
#pragma unroll
        for (int ai = 0; ai < 2; ++ai)
#pragma unroll
            for (int m = 0; m < 4; ++m)
#pragma unroll
                for (int bj = 0; bj < 2; ++bj) pre[ai][m][bj] = *(const u32x4*)(xb + (size_t)(row0 + ai * HALF + m * 16) * 1024 + col0 + bj * HALF);
#pragma unroll
        for (int ai = 0; ai < 2; ++ai)
#pragma unroll
            for (int m = 0; m < 4; ++m) {
                const int row = row0 + ai * HALF + m * 16; float q = 0.f;
#pragma unroll
                for (int bj = 0; bj < 2; ++bj) {
                    const u32x4 b = pre[ai][m][bj];
                    f32x4 v0 = acc[ai][bj][m][0], v1 = acc[ai][bj][m][1];
                    v0[0] += __builtin_bit_cast(float, b.x << 16); v0[1] += __builtin_bit_cast(float, b.x & 0xffff0000u); v0[2] += __builtin_bit_cast(float, b.y << 16); v0[3] += __builtin_bit_cast(float, b.y & 0xffff0000u);
                    v1[0] += __builtin_bit_cast(float, b.z << 16); v1[1] += __builtin_bit_cast(float, b.z & 0xffff0000u); v1[2] += __builtin_bit_cast(float, b.w << 16); v1[3] += __builtin_bit_cast(float, b.w & 0xffff0000u);
                    q += (v0[0] * v0[0] + v0[1] * v0[1]) + (v0[2] * v0[2] + v0[3] * v0[3]) + (v1[0] * v1[0] + v1[1] * v1[1]) + (v1[2] * v1[2] + v1[3] * v1[3]);
                    u32x4 w; w.x = cvt_pk_bf16(v0[0], v0[1]); w.y = cvt_pk_bf16(v0[2], v0[3]); w.z = cvt_pk_bf16(v1[0], v1[1]); w.w = cvt_pk_bf16(v1[2], v1[3]);
                    *(u32x4*)(xb + (size_t)row * 1024 + col0 + bj * HALF) = w;
                }
                q += __shfl_xor(q, 16); q += __shfl_xor(q, 32);
                if (fq == 0) ssq[(size_t)row * 16 + u.pn * 4 + wc] = q;
            }
    }
};
struct FastOrder {
    int nq, sh, nwg, q, G, c;
    __device__ __forceinline__ void init(int M_, int N_, int G_, int c_) { const int nN = N_ / BM; nq = nN >> 2; sh = nq >> 1; nwg = (M_ / BM) * nN; q = nwg >> 3; G = G_; c = c_; }
    __device__ __forceinline__ bool next(int i, Unit& u) const {
        const int L = i * G + c; if (L >= nwg) return false;
        const int wgid = (L & 7) * q + (L >> 3);
        const int y = wgid >> 5;
        const int gid = (nq == 3) ? ((y * 43691) >> 17) : (y >> sh);
        const int rem = wgid - gid * (nq << 5);
        u.pm = gid * 8 + (rem & 7); u.pn = rem >> 3; return true;
    }
    __device__ __forceinline__ void a_ready(const Unit&) const {}
    __device__ __forceinline__ void done(const Unit&) const {}
};
template <class Epi, class Sched, bool ALIGN_EPI = false, bool SP2 = false>
__device__ __forceinline__ void gemm_phase(PG8_LAS unsigned char* lds, const Gemm g, const Sched& S, const Epi& E) {
    int tid_ = threadIdx.x; asm volatile("" : "+v"(tid_));
    const int tid = tid_, wid = __builtin_amdgcn_readfirstlane(tid >> 6), lane = tid & 63, wr = wid >> 2, wc = wid & 3, fr = lane & 15, fq = lane >> 4;
    const int K = g.K, nt = K / BK;
    unsigned voffA, voffB;
    { int R, C; stage_rc(tid * 16, R, C); const int Rb = Epi::PERM ? ((R & ~31) + perm32(R & 31)) : R;
        voffA = (unsigned)(R * K + C) * 2u; voffB = (unsigned)(Rb * K + C) * 2u; }
    const size_t qstep = (size_t)64 * K * 2;
    const size_t kstep = (size_t)(BK * 2);
    const size_t hstep = (size_t)HALF * K * 2;
    const size_t tstep = 2 * hstep;
    const unsigned ldsw = (unsigned)wid * 1024u;
    const int aoff = lds_byte(wr * 64 + fr, fq * 8), boff = lds_byte(wc * 32 + fr, fq * 8);
#define PG8_SA(b, h) (((b) * 2 + (h)) * HTB)
#define PG8_SB(b, h) ((4 + (b) * 2 + (h)) * HTB)
#define PG8_STAGE(bufoff, gbase, voff) do { _Pragma("unroll") for (int _i = 0; _i < 2; ++_i) \
        __builtin_amdgcn_global_load_lds((const unsigned*)((const char*)(gbase) + _i * qstep + (voff)), (PG8_LAS unsigned*)(lds + (bufoff) + ldsw + _i * 8192), 16, 0, 0); } while (0)
#define PG8_LDA(dst, b, h) do { _Pragma("unroll") for (int m = 0; m < 4; ++m) _Pragma("unroll") for (int k = 0; k < 2; ++k) dst[m][k] = *(const PG8_LAS bf16x8*)(lds + PG8_SA(b, h) + aoff + m * 2048 + k * 1024); } while (0)
#define PG8_LDB(dst, b, h) do { _Pragma("unroll") for (int n = 0; n < 2; ++n) _Pragma("unroll") for (int k = 0; k < 2; ++k) dst[n][k] = *(const PG8_LAS bf16x8*)(lds + PG8_SB(b, h) + boff + n * 2048 + k * 1024); } while (0)
#define PG8_MMA(ai, bj, At, Bt) do { __builtin_amdgcn_s_setprio(1); _Pragma("unroll") for (int m = 0; m < 4; ++m) _Pragma("unroll") for (int n = 0; n < 2; ++n) _Pragma("unroll") for (int k = 0; k < 2; ++k) \
        acc[ai][bj][m][n] = __builtin_amdgcn_mfma_f32_16x16x32_bf16(Bt[n][k], At[m][k], acc[ai][bj][m][n], 0, 0, 0); __builtin_amdgcn_s_setprio(0); } while (0)
#define PG8_WAIT_V(n) asm volatile("s_waitcnt vmcnt(" #n ")" ::: "memory")
#define PG8_WAIT_L(n) asm volatile("s_waitcnt lgkmcnt(" #n ")" ::: "memory")
#define PG8_BAR __builtin_amdgcn_s_barrier()
#define PG8_SCHED __builtin_amdgcn_sched_barrier(0)
    Unit cur, nxt; int ui = 0;
    if (!S.next(0, cur)) return;
    f32x4 acc[2][2][4][2];
#pragma unroll
    for (int a = 0; a < 2; ++a)
#pragma unroll
        for (int b = 0; b < 2; ++b)
#pragma unroll
            for (int m = 0; m < 4; ++m)
#pragma unroll
                for (int n = 0; n < 2; ++n) acc[a][b][m][n] = (f32x4){0.f, 0.f, 0.f, 0.f};
    bf16x8 At[4][2], B0[2][2], B1[2][2];
    const char* cA = (const char*)g.A + (size_t)cur.pm * tstep; const char* cB = (const char*)g.Bt + (size_t)cur.pn * tstep;
    S.a_ready(cur);
    if constexpr (SP2) {
        PG8_STAGE(PG8_SB(0, 0), cB, voffB); PG8_STAGE(PG8_SB(0, 1), cB + hstep, voffB); PG8_STAGE(PG8_SA(0, 0), cA, voffA); PG8_STAGE(PG8_SA(0, 1), cA + hstep, voffA);
        E.prefill(S);
        if (wr == 1) PG8_BAR;
        PG8_WAIT_V(2); PG8_BAR;
        PG8_STAGE(PG8_SB(1, 0), cB + kstep, voffB); PG8_STAGE(PG8_SA(1, 0), cA + kstep, voffA); PG8_STAGE(PG8_SB(1, 1), cB + hstep + kstep, voffB);
        PG8_WAIT_V(6); PG8_BAR;
    } else {
        PG8_STAGE(PG8_SB(0, 0), cB, voffB); PG8_STAGE(PG8_SA(0, 0), cA, voffA); PG8_STAGE(PG8_SB(0, 1), cB + hstep, voffB); PG8_STAGE(PG8_SA(0, 1), cA + hstep, voffA);
        if (wr == 1) PG8_BAR;
        PG8_WAIT_V(4); PG8_BAR;
        PG8_STAGE(PG8_SB(1, 0), cB + kstep, voffB); PG8_STAGE(PG8_SA(1, 0), cA + kstep, voffA); PG8_STAGE(PG8_SB(1, 1), cB + hstep + kstep, voffB);
        PG8_WAIT_V(6); PG8_BAR;
    }
    for (;;) {
        const bool has_next = S.next(ui + 1, nxt);
        const char* nA = has_next ? (const char*)g.A + (size_t)nxt.pm * tstep : cA; const char* nB = has_next ? (const char*)g.Bt + (size_t)nxt.pn * tstep : cB;
        for (int t = 0; t < nt; t += 2) {
            const bool last = (t == nt - 2);
            const char* a1 = cA + (size_t)(t + 1) * kstep;
            const char* a2 = last ? nA : cA + (size_t)(t + 2) * kstep; const char* b2 = last ? nB : cB + (size_t)(t + 2) * kstep;
            const char* a3 = a2 + kstep; const char* b3 = b2 + kstep;
            if (last && has_next) S.a_ready(nxt);
            if constexpr (SP2) {
            PG8_LDB(B0, 0, 0); PG8_LDB(B1, 0, 1); PG8_SCHED; PG8_LDA(At, 0, 0); PG8_STAGE(PG8_SA(1, 1), a1 + hstep, voffA);
            PG8_WAIT_V(8); PG8_WAIT_L(0); PG8_BAR; PG8_MMA(0, 0, At, B0); PG8_MMA(0, 1, At, B1); PG8_BAR; PG8_SCHED;
            PG8_LDA(At, 0, 1); PG8_STAGE(PG8_SB(0, 0), b2, voffB); PG8_STAGE(PG8_SB(0, 1), b2 + hstep, voffB); PG8_STAGE(PG8_SA(0, 0), a2, voffA);
            PG8_WAIT_V(8); PG8_WAIT_L(0); PG8_BAR; PG8_MMA(1, 0, At, B0); PG8_MMA(1, 1, At, B1); PG8_BAR; PG8_SCHED;
            PG8_LDB(B0, 1, 0); PG8_LDB(B1, 1, 1); PG8_SCHED; PG8_LDA(At, 1, 0); PG8_STAGE(PG8_SA(0, 1), a2 + hstep, voffA);
            PG8_WAIT_V(8); PG8_WAIT_L(0); PG8_BAR; PG8_MMA(0, 0, At, B0); PG8_MMA(0, 1, At, B1); PG8_BAR; PG8_SCHED;
            PG8_LDA(At, 1, 1); PG8_STAGE(PG8_SB(1, 0), b3, voffB); PG8_STAGE(PG8_SB(1, 1), b3 + hstep, voffB); PG8_STAGE(PG8_SA(1, 0), a3, voffA);
            PG8_WAIT_V(8); PG8_WAIT_L(0); PG8_BAR; PG8_MMA(1, 0, At, B0); PG8_MMA(1, 1, At, B1); PG8_BAR; PG8_SCHED;
            } else {
            PG8_LDB(B0, 0, 0); PG8_SCHED; PG8_LDA(At, 0, 0); PG8_STAGE(PG8_SA(1, 1), a1 + hstep, voffA);
            PG8_WAIT_L(8); PG8_BAR; PG8_WAIT_L(0); PG8_MMA(0, 0, At, B0); PG8_BAR; PG8_SCHED;
            PG8_LDB(B1, 0, 1); PG8_STAGE(PG8_SB(0, 0), b2, voffB);
            PG8_BAR; PG8_WAIT_L(0); PG8_MMA(0, 1, At, B1); PG8_BAR;
            PG8_LDA(At, 0, 1); PG8_STAGE(PG8_SA(0, 0), a2, voffA);
            PG8_BAR; PG8_WAIT_L(0); PG8_MMA(1, 0, At, B0); PG8_BAR; PG8_SCHED;
            PG8_STAGE(PG8_SB(0, 1), b2 + hstep, voffB);
            PG8_WAIT_V(6); PG8_BAR; PG8_MMA(1, 1, At, B1); PG8_BAR;
            PG8_LDB(B0, 1, 0); PG8_SCHED; PG8_LDA(At, 1, 0); PG8_STAGE(PG8_SA(0, 1), a2 + hstep, voffA);
            PG8_WAIT_L(8); PG8_BAR; PG8_WAIT_L(0); PG8_MMA(0, 0, At, B0); PG8_BAR; PG8_SCHED;
            PG8_LDB(B1, 1, 1); PG8_STAGE(PG8_SB(1, 0), b3, voffB);
            PG8_BAR; PG8_WAIT_L(0); PG8_MMA(0, 1, At, B1); PG8_BAR;
            PG8_LDA(At, 1, 1); PG8_STAGE(PG8_SA(1, 0), a3, voffA);
            PG8_BAR; PG8_WAIT_L(0); PG8_MMA(1, 0, At, B0); PG8_BAR; PG8_SCHED;
            PG8_STAGE(PG8_SB(1, 1), b3 + hstep, voffB);
            PG8_WAIT_V(6); PG8_BAR; PG8_MMA(1, 1, At, B1); PG8_BAR;
            }
        }
        if constexpr (ALIGN_EPI) { if (wr == 0) PG8_BAR; }
        if constexpr (!Epi::AFTER_DRAIN) { E(acc, cur, wr, wc, fr, fq); S.done(cur); }
        if (!has_next) break;
#pragma unroll
        for (int a = 0; a < 2; ++a)
#pragma unroll
            for (int b = 0; b < 2; ++b)
#pragma unroll
                for (int m = 0; m < 4; ++m)
#pragma unroll
                    for (int n = 0; n < 2; ++n) acc[a][b][m][n] = (f32x4){0.f, 0.f, 0.f, 0.f};
        cur = nxt; cA = nA; cB = nB; ++ui;
        if constexpr (ALIGN_EPI) { if (wr == 1) PG8_BAR; }
    }
    PG8_WAIT_V(0);
    if constexpr (!ALIGN_EPI) { if (wr == 0) PG8_BAR; }
    PG8_BAR;
    if constexpr (Epi::AFTER_DRAIN) { E.fused(acc, cur, wr, wc, fr, fq, lds, wid, lane); S.done(cur); }
#undef PG8_SA
#undef PG8_SB
#undef PG8_STAGE
#undef PG8_LDA
#undef PG8_LDB
#undef PG8_MMA
#undef PG8_WAIT_V
#undef PG8_WAIT_L
#undef PG8_BAR
#undef PG8_SCHED
}
}
#define LAS __attribute__((address_space(3)))
#define XB_TMO      128
#define XB_XCNT(j)  (256  + 64 * (j))
#define XB_XSUB(j)  (1280 + 64 * (j))
#define XB_XGEN(j)  (2304 + 64 * (j))
#define XB_TOP      3328
#define XB_TOPGEN   3392
#define XCD_BAR_WORDS 3456
#define XB_SPIN_CAP (1u << 22)

__device__ __forceinline__ unsigned xb_ld(unsigned* p)              { return __hip_atomic_load(p, __ATOMIC_RELAXED, __HIP_MEMORY_SCOPE_AGENT); }
__device__ __forceinline__ unsigned xb_add(unsigned* p, unsigned v) { return __hip_atomic_fetch_add(p, v, __ATOMIC_RELAXED, __HIP_MEMORY_SCOPE_AGENT); }
__device__ __forceinline__ unsigned xb_xcc_id() { return (unsigned)__builtin_amdgcn_s_getreg((3 << 11) | 20) & 0xFu; }
#define XB_SPIN(cond, bar) do { unsigned _sp = 0; while (cond) { __builtin_amdgcn_s_sleep(1); \
    if ((++_sp & 255u) == 0u) { if (xb_ld(&(bar)[XB_TMO])) break; if (_sp > XB_SPIN_CAP) { atomicAdd(&(bar)[XB_TMO], 1u); break; } } } } while (0)

struct XcdBarrier {
    unsigned* bar; unsigned x;
    volatile LAS unsigned* st;
};

__device__ __forceinline__ XcdBarrier xcd_barrier_post(unsigned* bar, volatile LAS unsigned* st) {
    XcdBarrier b; b.bar = bar; b.x = xb_xcc_id(); b.st = st;
    if (threadIdx.x == 0) (void)xb_add(&bar[XB_XCNT(b.x)], 1u);
    return b;
}
__device__ __forceinline__ void xcd_barrier_complete(unsigned* bar, unsigned x, unsigned& nloc, unsigned& nx) {
    const unsigned G = gridDim.x * gridDim.y * gridDim.z;
    unsigned sum, cnt, mine, sp = 0u;
    for (;;) {
        sum = 0u; cnt = 0u; mine = 0u;
#pragma unroll
        for (unsigned j = 0; j < 16; ++j) { const unsigned c = xb_ld(&bar[XB_XCNT(j)]); sum += c; cnt += (c > 0u) ? 1u : 0u; mine = (j == x) ? c : mine; }
        if (sum == G) break;
        __builtin_amdgcn_s_sleep(1);
        if ((++sp & 255u) == 0u) { if (xb_ld(&bar[XB_TMO])) break; if (sp > XB_SPIN_CAP) { atomicAdd(&bar[XB_TMO], 1u); break; } }
    }
    nloc = mine > 0u ? mine : 1u; nx = cnt > 0u ? cnt : 1u;
}

__device__ __forceinline__ void xcd_barrier(const XcdBarrier& b) {
    asm volatile("s_waitcnt vmcnt(0)" ::: "memory");
    __syncthreads();
    if (threadIdx.x == 0) {
        unsigned* bar = b.bar;
        __builtin_amdgcn_s_waitcnt(0);
        unsigned nloc = b.st[0], nx = b.st[1];
        if (nloc == 0u) { xcd_barrier_complete(bar, b.x, nloc, nx); b.st[0] = nloc; b.st[1] = nx; }
        const unsigned old = xb_add(&bar[XB_XSUB(b.x)], 1u);
        const unsigned gen = old / nloc;
        if (old + 1u == (gen + 1u) * nloc) {
            __builtin_amdgcn_fence(__ATOMIC_RELEASE, "agent");
            asm volatile("s_waitcnt vmcnt(0)" ::: "memory");
            const unsigned og = xb_add(&bar[XB_TOP], 1u);
            const unsigned tg = og / nx;
            if (og + 1u == (tg + 1u) * nx) xb_add(&bar[XB_TOPGEN], 1u);
            else XB_SPIN(xb_ld(&bar[XB_TOPGEN]) == tg, bar);
            __builtin_amdgcn_fence(__ATOMIC_ACQUIRE, "agent");
            xb_add(&bar[XB_XGEN(b.x)], 1u);
            asm volatile("s_waitcnt vmcnt(0)" ::: "memory");
        } else {
            XB_SPIN(xb_ld(&bar[XB_XGEN(b.x)]) == gen, bar);
            __builtin_amdgcn_fence(__ATOMIC_ACQUIRE, "agent");
            asm volatile("s_waitcnt vmcnt(0)" ::: "memory");
        }
    }
    __syncthreads();
}

#include <hip/hip_cooperative_groups.h>
namespace cg = cooperative_groups;
typedef pg8::bf16_t bf16_t;
typedef pg8::bf16x8 bf16x8;
typedef pg8::f32x4 f32x4;
typedef pg8::u32x4 u32x4;
typedef float f32x16 __attribute__((ext_vector_type(16)));
typedef float f32x2 __attribute__((ext_vector_type(2)));
typedef unsigned u32x2 __attribute__((ext_vector_type(2)));
typedef short v4i16_t __attribute__((ext_vector_type(4)));

constexpr int BATCH = 16, SEQ = 2048, DM = 1024, M = BATCH * SEQ, DEPTH = 4, FF = 4096, NHEAD = 16;
constexpr int NWAVES = 8;
#ifndef MK_ONE_LAUNCH
#define MK_ONE_LAUNCH 1
#endif
constexpr size_t MiB = 1u << 20;
constexpr size_t WS_SSQ = 1 * MiB;
constexpr size_t WS_W1 = 4 * MiB, WS_W2 = 36 * MiB, WS_WQKV = 68 * MiB, WS_WO = 80 * MiB, WS_WIN = 84 * MiB, WS_WRO = 92 * MiB;
constexpr size_t WS_XB = 96 * MiB;
constexpr size_t WS_BIG = 160 * MiB;
constexpr size_t WS_END = 416 * MiB;
constexpr int LDS_BYTES = 147456;
constexpr int NPHASE = 1 + 5 * DEPTH + 1;

__device__ __forceinline__ unsigned f2bf(float f) { unsigned u = __builtin_bit_cast(unsigned, f); return (u + 0x7fffu + ((u >> 16) & 1u)) >> 16; }
__device__ __forceinline__ unsigned pk2(float lo, float hi) { return f2bf(lo) | (f2bf(hi) << 16); }
__device__ __forceinline__ float bf_lo(unsigned w) { return __builtin_bit_cast(float, w << 16); }
__device__ __forceinline__ float bf_hi(unsigned w) { return __builtin_bit_cast(float, w & 0xffff0000u); }
__device__ __forceinline__ float wave_sum(float v) {
#pragma unroll
    for (int o = 1; o < 64; o <<= 1) v += __shfl_xor(v, o);
    return v;
}

__device__ __forceinline__ void p0_transpose_item(const float* W, int K, int N, bf16_t* WT, const float* gain, LAS float* scr, int item, int lane) {
    const int nblk = N / 32, kb = item / nblk, nb = item % nblk, k0 = 64 * kb, n0 = 32 * nb;
    float wv[32];
#pragma unroll
    for (int i = 0; i < 32; ++i) { const int kk = 2 * i + (lane >> 5); wv[i] = W[(size_t)(k0 + kk) * N + n0 + (lane & 31)]; }
#pragma unroll
    for (int i = 0; i < 32; ++i) { const int kk = 2 * i + (lane >> 5); const float g = gain ? gain[k0 + kk] : 1.0f; scr[kk * 33 + (lane & 31)] = wv[i] * g; }
    asm volatile("s_waitcnt lgkmcnt(0)" ::: "memory");
    const int c = lane & 7;
#pragma unroll
    for (int j = 0; j < 4; ++j) { const int n = (lane >> 3) + 8 * j; const LAS float* s = scr + (8 * c) * 33 + n;
        u32x4 o; o.x = pk2(s[0 * 33], s[1 * 33]); o.y = pk2(s[2 * 33], s[3 * 33]); o.z = pk2(s[4 * 33], s[5 * 33]); o.w = pk2(s[6 * 33], s[7 * 33]);
        *(u32x4*)(WT + (size_t)(n0 + n) * K + k0 + 8 * c) = o; }
    asm volatile("s_waitcnt lgkmcnt(0)" ::: "memory");
}

struct Args { const float* in[17]; float* out; unsigned char* ws; int ph_lo, ph_hi; };
typedef const __attribute__((address_space(4))) Args* ArgsP;
__device__ __forceinline__ ArgsP kargs() {
    const unsigned long long p = (unsigned long long)__builtin_amdgcn_kernarg_segment_ptr();
    unsigned lo = (unsigned)p, hi = (unsigned)(p >> 32);
    asm volatile("" : "+s"(lo), "+s"(hi));
    lo = __builtin_amdgcn_readfirstlane(lo); hi = __builtin_amdgcn_readfirstlane(hi);
    return (ArgsP)(((unsigned long long)hi << 32) | lo);
}
#define KA (kargs())
#define PHASE_IDS() int tid_ = threadIdx.x; asm volatile("" : "+v"(tid_)); const int tid = tid_, lane = tid & 63, wave = __builtin_amdgcn_readfirstlane(tid >> 6); \
    int bx_ = blockIdx.x; asm volatile("" : "+s"(bx_)); bx_ = __builtin_amdgcn_readfirstlane(bx_); int Gn_ = gridDim.x; asm volatile("" : "+s"(Gn_)); Gn_ = __builtin_amdgcn_readfirstlane(Gn_); const int vcu_ = (Gn_ % 8 == 0) ? (bx_ % 8) * (Gn_ / 8) + bx_ / 8 : bx_; const int gw = vcu_ * NWAVES + wave, ngw = Gn_ * NWAVES; (void)tid; (void)lane; (void)gw; (void)ngw

__device__ __forceinline__ void p0_prologue(LAS unsigned char* lds) {
    PHASE_IDS();
    LAS float* scr = (LAS float*)(lds + wave * 16384);
    ArgsP ap = KA; unsigned char* ws = ap->ws;
    constexpr int I_W1 = 16 * 128, I_W2 = 64 * 32, I_QKV = 16 * 96, I_WO = 16 * 32, I_WIN = 16 * 64;
    constexpr int NITEMS = 4 * I_W1 + 4 * I_W2 + 2 * I_QKV + 2 * I_WO + 2 * I_WIN + 2 * I_WO;
    for (int it = gw; it < NITEMS; it += ngw) {
        int r = it;
        if (r < 4 * I_W1) { const int l = r / I_W1; p0_transpose_item(ap->in[3] + (size_t)l * DM * FF, DM, FF, (bf16_t*)(ws + WS_W1) + (size_t)l * DM * FF, ap->in[2] + l * DM, scr, r % I_W1, lane); continue; } r -= 4 * I_W1;
        if (r < 4 * I_W2) { const int l = r / I_W2; p0_transpose_item(ap->in[4] + (size_t)l * DM * FF, FF, DM, (bf16_t*)(ws + WS_W2) + (size_t)l * DM * FF, nullptr, scr, r % I_W2, lane); continue; } r -= 4 * I_W2;
        if (r < 2 * I_QKV) { const int l = r / I_QKV; p0_transpose_item(ap->in[5] + (size_t)l * DM * 3 * DM, DM, 3 * DM, (bf16_t*)(ws + WS_WQKV) + (size_t)l * DM * 3 * DM, ap->in[1] + (2 * l) * DM, scr, r % I_QKV, lane); continue; } r -= 2 * I_QKV;
        if (r < 2 * I_WO) { const int l = r / I_WO; p0_transpose_item(ap->in[6] + (size_t)l * DM * DM, DM, DM, (bf16_t*)(ws + WS_WO) + (size_t)l * DM * DM, nullptr, scr, r % I_WO, lane); continue; } r -= 2 * I_WO;
        if (r < 2 * I_WIN) { const int l = r / I_WIN; p0_transpose_item(ap->in[7] + (size_t)l * DM * 2 * DM, DM, 2 * DM, (bf16_t*)(ws + WS_WIN) + (size_t)l * DM * 2 * DM, ap->in[1] + (2 * l + 1) * DM, scr, r % I_WIN, lane); continue; } r -= 2 * I_WIN;
        { const int l = r / I_WO; p0_transpose_item(ap->in[15] + (size_t)l * DM * DM, DM, DM, (bf16_t*)(ws + WS_WRO) + (size_t)l * DM * DM, nullptr, scr, r % I_WO, lane); }
    }
    const float* x = ap->in[0]; bf16_t* xb = (bf16_t*)(ws + WS_XB); float* ssq = (float*)(ws + WS_SSQ);
    for (int m0 = gw * 4; m0 < M; m0 += ngw * 4) {
        f32x4 v[4][4];
#pragma unroll
        for (int r = 0; r < 4; ++r)
#pragma unroll
            for (int j = 0; j < 4; ++j) v[r][j] = ((const f32x4*)(x + (size_t)(m0 + r) * DM) + lane)[64 * j];
#pragma unroll
        for (int r = 0; r < 4; ++r) {
            u32x2* o8 = (u32x2*)(xb + (size_t)(m0 + r) * DM) + lane; float s = 0.f;
#pragma unroll
            for (int j = 0; j < 4; ++j) { const f32x4 t = v[r][j]; s += (t.x * t.x + t.y * t.y) + (t.z * t.z + t.w * t.w); u32x2 w; w.x = pk2(t.x, t.y); w.y = pk2(t.z, t.w); o8[64 * j] = w; }
            s = wave_sum(s);
            if (lane < 16) ssq[(size_t)(m0 + r) * 16 + lane] = (lane == 0) ? s : 0.f;
        }
    }
}

__device__ __forceinline__ void final_norm(float* out, const bf16_t* xb, const float* ssq, const float* g) {
    PHASE_IDS();
    f32x4 gg[4];
#pragma unroll
    for (int j = 0; j < 4; ++j) gg[j] = ((const f32x4*)g + lane)[64 * j];
    for (int m0 = gw * 4; m0 < M; m0 += ngw * 4) {
        u32x2 w[4][4]; float rs[4];
#pragma unroll
        for (int r = 0; r < 4; ++r) {
#pragma unroll
            for (int j = 0; j < 4; ++j) w[r][j] = ((const u32x2*)(xb + (size_t)(m0 + r) * DM) + lane)[64 * j];
            rs[r] = pg8::row_rstd(ssq, m0 + r);
        }
#pragma unroll
        for (int r = 0; r < 4; ++r) {
            f32x4* orow = (f32x4*)(out + (size_t)(m0 + r) * DM) + lane;
#pragma unroll
            for (int j = 0; j < 4; ++j) { const f32x4 v = {bf_lo(w[r][j].x), bf_hi(w[r][j].x), bf_lo(w[r][j].y), bf_hi(w[r][j].y)}; __builtin_nontemporal_store(v * rs[r] * gg[j], &orow[64 * j]); }
        }
    }
}

__device__ __forceinline__ int crow(int r, int hi) { return (r & 3) + 8 * (r >> 2) + 4 * hi; }
constexpr int VPITCH = 144;
template <bool DIAG> __device__ __forceinline__ void att_elem(const f32x16& s, float& P, int j, int hi, bf16x8& pb0, bf16x8& pb1) {
    float w[16], T[4];
#pragma unroll
    for (int g = 0; g < 4; ++g) {
        float bt[4], kp[4];
#pragma unroll
        for (int e = 0; e < 4; ++e) {
            const int r = 4 * g + e;
            float nz; asm("v_min_f32_e64 %0, -%1, %2" : "=v"(nz) : "v"(s[r]), "s"(100.0f));
            const float ex = __builtin_amdgcn_exp2f(nz);
            float be = __builtin_amdgcn_rcpf(1.0f + ex); float ke = ex * be;
            if (DIAG && !(crow(r, hi) < j)) { be = 0.f; ke = 1.f; }
            bt[e] = be; kp[e] = ke;
        }
        const float s2 = kp[3], s1 = s2 * kp[2], s0 = s1 * kp[1];
        w[4 * g + 3] = bt[3]; w[4 * g + 2] = bt[2] * s2; w[4 * g + 1] = bt[1] * s1; w[4 * g + 0] = bt[0] * s0; T[g] = s0 * kp[0];
    }
    float sp3 = P, U[4], pr[4];
#pragma unroll
    for (int g = 0; g < 4; ++g) { U[g] = __shfl_xor(T[g], 32); pr[g] = T[g] * U[g]; }
    const float sp2 = sp3 * pr[3], sp1 = sp2 * pr[2], sp0 = sp1 * pr[1];
    P = sp0 * pr[0];
    { const float m3 = sp3 * (hi ? 1.0f : U[3]), m2 = sp2 * (hi ? 1.0f : U[2]), m1 = sp1 * (hi ? 1.0f : U[1]), m0 = sp0 * (hi ? 1.0f : U[0]);
#pragma unroll
      for (int e = 0; e < 4; ++e) { w[e] *= m0; w[4 + e] *= m1; w[8 + e] *= m2; w[12 + e] *= m3; } }
    u32x4 p0, p1;
    p0.x = pg8::cvt_pk_bf16(w[0], w[1]); p0.y = pg8::cvt_pk_bf16(w[2], w[3]); p0.z = pg8::cvt_pk_bf16(w[4], w[5]); p0.w = pg8::cvt_pk_bf16(w[6], w[7]);
    p1.x = pg8::cvt_pk_bf16(w[8], w[9]); p1.y = pg8::cvt_pk_bf16(w[10], w[11]); p1.z = pg8::cvt_pk_bf16(w[12], w[13]); p1.w = pg8::cvt_pk_bf16(w[14], w[15]);
    pb0 = __builtin_bit_cast(bf16x8, p0); pb1 = __builtin_bit_cast(bf16x8, p1);
}
__device__ __forceinline__ void attn_phase(LAS unsigned char* lds, const bf16_t* __restrict__ Q, const bf16_t* __restrict__ K, const bf16_t* __restrict__ V, bf16_t* __restrict__ O) {
    PHASE_IDS();
    LAS unsigned char* vl = lds + wave * (32 * VPITCH);
    const int j = lane & 31, hi = lane >> 5;
    const int g16 = lane >> 4, dsel = g16 & 1, qq = (lane & 15) >> 2, pp = lane & 3;
    const LAS unsigned char* vrd = vl + (4 * hi + qq) * VPITCH + (16 * dsel + 4 * pp) * 2;
#define VTR(off) __builtin_amdgcn_ds_read_tr16_b64_v4i16((LAS v4i16_t*)(vrd + (off)))
#define VFRAG(db, ks) ({ const v4i16_t lo_ = VTR((16 * (ks)) * VPITCH + (db) * 64), hi_ = VTR((16 * (ks) + 8) * VPITCH + (db) * 64); (bf16x8){lo_[0], lo_[1], lo_[2], lo_[3], hi_[0], hi_[1], hi_[2], hi_[3]}; })
#define ATT_LOADKV(KT) do { const bf16_t* Kp = K + (rowb + (KT) * 32 + j) * DM + h * 64 + hi * 8; \
            _Pragma("unroll") for (int d0 = 0; d0 < 4; ++d0) kf[d0] = *(const bf16x8*)(Kp + d0 * 16); \
            _Pragma("unroll") for (int i = 0; i < 4; ++i) { const int c = lane + 64 * i; vst[i] = *(const u32x4*)(V + (rowb + (KT) * 32 + (c >> 3)) * DM + h * 64 + (c & 7) * 8); } } while (0)
#define ATT_STAGEV() do { _Pragma("unroll") for (int i = 0; i < 4; ++i) { const int c = lane + 64 * i; *(LAS u32x4*)(vl + (c >> 3) * VPITCH + (c & 7) * 16) = vst[i]; } } while (0)
#define ATT_QK(S, QF) do { S = (f32x16){}; _Pragma("unroll") for (int d0 = 0; d0 < 4; ++d0) S = __builtin_amdgcn_mfma_f32_32x32x16_bf16(kf[d0], QF[d0], S, 0, 0, 0); } while (0)
#define ATT_PV(OA, OB, PB0, PB1) do { OA = __builtin_amdgcn_mfma_f32_32x32x16_bf16(v00, PB0, OA, 0, 0, 0); OA = __builtin_amdgcn_mfma_f32_32x32x16_bf16(v01, PB1, OA, 0, 0, 0); \
            OB = __builtin_amdgcn_mfma_f32_32x32x16_bf16(v10, PB0, OB, 0, 0, 0); OB = __builtin_amdgcn_mfma_f32_32x32x16_bf16(v11, PB1, OB, 0, 0, 0); } while (0)
#define ATT_ALIVE(P) (__builtin_amdgcn_ballot_w64((P) >= 1.17549435e-38f) != 0ull)
    for (int unit = gw; unit < BATCH * NHEAD * (SEQ / 64); unit += ngw) {
        const int qp = unit & 31, bh = unit >> 5, b = bh >> 4, h = bh & 15;
        const size_t rowb = (size_t)b * SEQ; const int q0 = qp * 64;
        bf16x8 qfa[4], qfb[4];
        { const bf16_t* Qp = Q + (rowb + q0 + j) * DM + h * 64 + hi * 8;
#pragma unroll
          for (int d0 = 0; d0 < 4; ++d0) { qfa[d0] = *(const bf16x8*)(Qp + d0 * 16); qfb[d0] = *(const bf16x8*)(Qp + 32 * DM + d0 * 16); } }
        f32x16 oa0 = {}, oa1 = {}, ob0 = {}, ob1 = {}; float Pa = 1.0f, Pb = 1.0f;
        bf16x8 kf[4]; u32x4 vst[4];
        const int top = 2 * qp + 1;
        { ATT_LOADKV(top); f32x16 sb; ATT_QK(sb, qfb); ATT_STAGEV(); asm volatile("s_nop 15\n\ts_nop 7" : "+v"(sb));
          bf16x8 pb0, pb1; att_elem<true>(sb, Pb, j, hi, pb0, pb1);
          asm volatile("s_waitcnt lgkmcnt(0)" ::: "memory");
          const bf16x8 v00 = VFRAG(0, 0), v01 = VFRAG(0, 1), v10 = VFRAG(1, 0), v11 = VFRAG(1, 1); ATT_PV(ob0, ob1, pb0, pb1);
          asm volatile("s_waitcnt lgkmcnt(0)" ::: "memory"); }
        { ATT_LOADKV(top - 1); f32x16 sa, sb; ATT_QK(sa, qfa); ATT_QK(sb, qfb); ATT_STAGEV(); asm volatile("s_nop 15\n\ts_nop 7" : "+v"(sa), "+v"(sb));
          bf16x8 pa0, pa1, pb0, pb1; att_elem<true>(sa, Pa, j, hi, pa0, pa1); att_elem<false>(sb, Pb, j, hi, pb0, pb1);
          asm volatile("s_waitcnt lgkmcnt(0)" ::: "memory");
          const bf16x8 v00 = VFRAG(0, 0), v01 = VFRAG(0, 1), v10 = VFRAG(1, 0), v11 = VFRAG(1, 1); ATT_PV(oa0, oa1, pa0, pa1); ATT_PV(ob0, ob1, pb0, pb1);
          asm volatile("s_waitcnt lgkmcnt(0)" ::: "memory"); }
        bool alive_a = ATT_ALIVE(Pa), alive_b = ATT_ALIVE(Pb);
        for (int kt = top - 2; kt >= 0 && (alive_a || alive_b); --kt) {
            ATT_LOADKV(kt);
            if (alive_a && alive_b) {
                f32x16 sa, sb; ATT_QK(sa, qfa); ATT_QK(sb, qfb); ATT_STAGEV(); asm volatile("s_nop 15\n\ts_nop 7" : "+v"(sa), "+v"(sb));
                bf16x8 pa0, pa1, pb0, pb1; att_elem<false>(sa, Pa, j, hi, pa0, pa1); att_elem<false>(sb, Pb, j, hi, pb0, pb1);
                asm volatile("s_waitcnt lgkmcnt(0)" ::: "memory");
                const bf16x8 v00 = VFRAG(0, 0), v01 = VFRAG(0, 1), v10 = VFRAG(1, 0), v11 = VFRAG(1, 1); ATT_PV(oa0, oa1, pa0, pa1); ATT_PV(ob0, ob1, pb0, pb1);
                alive_a = ATT_ALIVE(Pa); alive_b = ATT_ALIVE(Pb);
            } else if (alive_a) {
                f32x16 sa; ATT_QK(sa, qfa); ATT_STAGEV(); asm volatile("s_nop 15\n\ts_nop 7" : "+v"(sa));
                bf16x8 pa0, pa1; att_elem<false>(sa, Pa, j, hi, pa0, pa1);
                asm volatile("s_waitcnt lgkmcnt(0)" ::: "memory");
                const bf16x8 v00 = VFRAG(0, 0), v01 = VFRAG(0, 1), v10 = VFRAG(1, 0), v11 = VFRAG(1, 1); ATT_PV(oa0, oa1, pa0, pa1);
                alive_a = ATT_ALIVE(Pa);
            } else {
                f32x16 sb; ATT_QK(sb, qfb); ATT_STAGEV(); asm volatile("s_nop 15\n\ts_nop 7" : "+v"(sb));
                bf16x8 pb0, pb1; att_elem<false>(sb, Pb, j, hi, pb0, pb1);
                asm volatile("s_waitcnt lgkmcnt(0)" ::: "memory");
                const bf16x8 v00 = VFRAG(0, 0), v01 = VFRAG(0, 1), v10 = VFRAG(1, 0), v11 = VFRAG(1, 1); ATT_PV(ob0, ob1, pb0, pb1);
                alive_b = ATT_ALIVE(Pb);
            }
            asm volatile("s_waitcnt lgkmcnt(0)" ::: "memory");
        }
        bf16_t* Op = O + (rowb + q0 + j) * DM + h * 64 + 4 * hi;
#pragma unroll
        for (int g = 0; g < 4; ++g) {
            u32x2 a, c; a.x = pg8::cvt_pk_bf16(oa0[4 * g], oa0[4 * g + 1]); a.y = pg8::cvt_pk_bf16(oa0[4 * g + 2], oa0[4 * g + 3]);
            c.x = pg8::cvt_pk_bf16(oa1[4 * g], oa1[4 * g + 1]); c.y = pg8::cvt_pk_bf16(oa1[4 * g + 2], oa1[4 * g + 3]);
            *(u32x2*)(Op + 8 * g) = a; *(u32x2*)(Op + 32 + 8 * g) = c;
            a.x = pg8::cvt_pk_bf16(ob0[4 * g], ob0[4 * g + 1]); a.y = pg8::cvt_pk_bf16(ob0[4 * g + 2], ob0[4 * g + 3]);
            c.x = pg8::cvt_pk_bf16(ob1[4 * g], ob1[4 * g + 1]); c.y = pg8::cvt_pk_bf16(ob1[4 * g + 2], ob1[4 * g + 3]);
            *(u32x2*)(Op + 32 * DM + 8 * g) = a; *(u32x2*)(Op + 32 * DM + 32 + 8 * g) = c;
        }
    }
#undef VTR
#undef VFRAG
#undef ATT_LOADKV
#undef ATT_STAGEV
#undef ATT_QK
#undef ATT_PV
#undef ATT_ALIVE
}

constexpr int RG_WF = 0, RG_CONST = 16384, RG_TOT = RG_CONST + 8 * 64 * 4, RG_LDS_END = RG_TOT + 2 * 8 * 64 * 8;
template <int CTRL> __device__ __forceinline__ float dpp_f(float old, float src) {
    return __builtin_bit_cast(float, __builtin_amdgcn_update_dpp(__builtin_bit_cast(int, old), __builtin_bit_cast(int, src), CTRL, 0xf, 0xf, false));
}
__device__ __forceinline__ float sigmoid_f(float x) { const float e = __builtin_amdgcn_exp2f(-fminf(fmaxf(x, -80.f), 80.f) * 1.4426950408889634f); return __builtin_amdgcn_rcpf(1.0f + e); }
__device__ __forceinline__ void rg_phase(LAS unsigned char* lds, int li) {
    PHASE_IDS();
    const int tl = lane & 15, kg = lane >> 4;
    for (int unit = blockIdx.x; unit < BATCH * 16; unit += gridDim.x) {
        const int b = unit >> 4, hb = unit & 15;
        __syncthreads();
        for (int f = tid; f < 2 * 4 * 2 * 64; f += 512) {
            const int ln = f & 63, ks = (f >> 6) & 1, jb = (f >> 7) & 3, mat = f >> 9; const int jr = ln & 15, kgg = ln >> 4;
            const float* Wm = (mat ? KA->in[12] : KA->in[10]) + (size_t)li * 16 * 4096 + (size_t)hb * 4096;
            float v[8];
#pragma unroll
            for (int e = 0; e < 8; ++e) v[e] = Wm[(16 * (2 * ks + (e >> 2)) + 4 * kgg + (e & 3)) * 64 + 16 * jb + jr];
            u32x4 o; o.x = pk2(v[0], v[1]); o.y = pk2(v[2], v[3]); o.z = pk2(v[4], v[5]); o.w = pk2(v[6], v[7]);
            *(LAS u32x4*)(lds + RG_WF + f * 16) = o;
        }
        for (int c = tid; c < 8 * 64; c += 512) {
            const int k = c >> 6, ch = hb * 64 + (c & 63); float v;
            if (k < 4) v = (KA->in[8] + li * 4 * DM)[k * 1024 + ch]; else if (k == 4) v = (KA->in[9] + li * DM)[ch]; else if (k == 5) v = -1.4426950408889634f * (KA->in[11] + li * DM)[ch]; else if (k == 6) v = -1.4426950408889634f * (KA->in[13] + li * DM)[ch];
            else { const float l = (KA->in[14] + li * DM)[ch]; const float y = __builtin_amdgcn_exp2f(-fabsf(l) * 1.4426950408889634f);
                   const float l1p = (y < 0.03f) ? y * (1.0f - y * (0.5f - y * (0.33333334f - y * 0.25f))) : __builtin_amdgcn_logf(1.0f + y) * 0.6931471805599453f;
                   v = -16.0f * (fmaxf(-l, 0.f) + l1p); }
            ((LAS float*)(lds + RG_CONST))[c] = v;
        }
        __syncthreads();
        float hc[16];
#pragma unroll
        for (int i = 0; i < 16; ++i) hc[i] = 0.f;
        const size_t rowb = (size_t)b * SEQ; const int cbase = hb * 64 + 4 * kg;
        const bf16_t* __restrict__ G = (const bf16_t*)(KA->ws + WS_BIG); const bf16_t* __restrict__ XP = G + (size_t)M * DM; bf16_t* __restrict__ Y = (bf16_t*)(KA->ws + WS_BIG) + 2 * (size_t)M * DM;
#define RG_LOAD(chunk_, XPA, GVA) do { const int t_ = (chunk_) * 128 + wave * 16 + tl; \
            _Pragma("unroll") for (int tap = 0; tap < 4; ++tap) { const int ts = t_ - 3 + tap; const bf16_t* xr = XP + (rowb + (ts > 0 ? ts : 0)) * DM + cbase; \
                _Pragma("unroll") for (int jb = 0; jb < 4; ++jb) XPA[tap][jb] = *(const u32x2*)(xr + 16 * jb); } \
            if ((chunk_) == 0 && wave == 0) { _Pragma("unroll") for (int tap = 0; tap < 3; ++tap) if (t_ - 3 + tap < 0) { _Pragma("unroll") for (int jb = 0; jb < 4; ++jb) XPA[tap][jb] = (u32x2){0u, 0u}; } } \
            _Pragma("unroll") for (int jb = 0; jb < 4; ++jb) GVA[jb] = *(const u32x2*)(G + (rowb + t_) * DM + cbase + 16 * jb); } while (0)
        u32x2 xpn[4][4], gvn[4];
        RG_LOAD(0, xpn, gvn);
        for (int chunk = 0; chunk < SEQ / 128; ++chunk) {
            const int t = chunk * 128 + wave * 16 + tl;
            float xc[16];
#pragma unroll
            for (int jb = 0; jb < 4; ++jb) {
                const f32x4 cb = *(const LAS f32x4*)(lds + RG_CONST + (4 * 64 + 16 * jb + 4 * kg) * 4);
                xc[4 * jb] = cb.x; xc[4 * jb + 1] = cb.y; xc[4 * jb + 2] = cb.z; xc[4 * jb + 3] = cb.w;
            }
#pragma unroll
            for (int tap = 0; tap < 4; ++tap) {
#pragma unroll
                for (int jb = 0; jb < 4; ++jb) {
                    const u32x2 xv = xpn[tap][jb];
                    const f32x4 cw = *(const LAS f32x4*)(lds + RG_CONST + (tap * 64 + 16 * jb + 4 * kg) * 4);
                    xc[4 * jb] += cw.x * bf_lo(xv.x); xc[4 * jb + 1] += cw.y * bf_hi(xv.x); xc[4 * jb + 2] += cw.z * bf_lo(xv.y); xc[4 * jb + 3] += cw.w * bf_hi(xv.y);
                }
            }
            u32x2 gv[4];
#pragma unroll
            for (int jb = 0; jb < 4; ++jb) gv[jb] = gvn[jb];
            { const int cn = (chunk + 1 < SEQ / 128) ? chunk + 1 : chunk; RG_LOAD(cn, xpn, gvn); }
            u32x4 xb0, xb1;
            xb0.x = pg8::cvt_pk_bf16(xc[0], xc[1]); xb0.y = pg8::cvt_pk_bf16(xc[2], xc[3]); xb0.z = pg8::cvt_pk_bf16(xc[4], xc[5]); xb0.w = pg8::cvt_pk_bf16(xc[6], xc[7]);
            xb1.x = pg8::cvt_pk_bf16(xc[8], xc[9]); xb1.y = pg8::cvt_pk_bf16(xc[10], xc[11]); xb1.z = pg8::cvt_pk_bf16(xc[12], xc[13]); xb1.w = pg8::cvt_pk_bf16(xc[14], xc[15]);
            const bf16x8 bx0 = __builtin_bit_cast(bf16x8, xb0), bx1 = __builtin_bit_cast(bf16x8, xb1);
            float av[16], bv[16];
#pragma unroll
            for (int jb = 0; jb < 4; ++jb) {
                f32x4 ra = {0.f, 0.f, 0.f, 0.f}, ri = {0.f, 0.f, 0.f, 0.f};
                const bf16x8 wa0 = *(const LAS bf16x8*)(lds + RG_WF + (((0 * 4 + jb) * 2 + 0) * 64 + lane) * 16), wa1 = *(const LAS bf16x8*)(lds + RG_WF + (((0 * 4 + jb) * 2 + 1) * 64 + lane) * 16);
                const bf16x8 wx0 = *(const LAS bf16x8*)(lds + RG_WF + (((1 * 4 + jb) * 2 + 0) * 64 + lane) * 16), wx1 = *(const LAS bf16x8*)(lds + RG_WF + (((1 * 4 + jb) * 2 + 1) * 64 + lane) * 16);
                ra = __builtin_amdgcn_mfma_f32_16x16x32_bf16(wa0, bx0, ra, 0, 0, 0); ra = __builtin_amdgcn_mfma_f32_16x16x32_bf16(wa1, bx1, ra, 0, 0, 0);
                ri = __builtin_amdgcn_mfma_f32_16x16x32_bf16(wx0, bx0, ri, 0, 0, 0); ri = __builtin_amdgcn_mfma_f32_16x16x32_bf16(wx1, bx1, ri, 0, 0, 0);
                const f32x4 ba = *(const LAS f32x4*)(lds + RG_CONST + (5 * 64 + 16 * jb + 4 * kg) * 4), bxx = *(const LAS f32x4*)(lds + RG_CONST + (6 * 64 + 16 * jb + 4 * kg) * 4);
                const f32x4 lu = *(const LAS f32x4*)(lds + RG_CONST + (7 * 64 + 16 * jb + 4 * kg) * 4);
#pragma unroll
                for (int r = 0; r < 4; ++r) {
                    const float rg = __builtin_amdgcn_rcpf(1.0f + __builtin_amdgcn_exp2f(__builtin_fmaf(ra[r], -1.4426950408889634f, ba[r])));
                    const float ig = __builtin_amdgcn_rcpf(1.0f + __builtin_amdgcn_exp2f(__builtin_fmaf(ri[r], -1.4426950408889634f, bxx[r])));
                    const float x2 = rg * lu[r];
                    const float a = __builtin_amdgcn_exp2f(x2 * 0.7213475204444817f);
                    const float ser = -x2 * (1.0f + x2 * (0.5f + x2 * (0.16666667f + x2 * (0.041666668f + x2 * 0.008333334f))));
                    const float m2 = (x2 > -0.25f) ? ser : (1.0f - a * a);
                    av[4 * jb + r] = a; bv[4 * jb + r] = __builtin_amdgcn_sqrtf(fmaxf(m2, 0.f)) * (ig * xc[4 * jb + r]);
                }
            }
#define RG_SCAN8(N, A0, A1, A2, A3, A4, A5, A6, A7, B0, B1, B2, B3, B4, B5, B6, B7) asm volatile("s_nop 1\n\t" \
                "v_fmac_f32_dpp %8, %8, %0 row_shr:" #N " row_mask:0xf bank_mask:0xf\n\t" "v_fmac_f32_dpp %9, %9, %1 row_shr:" #N " row_mask:0xf bank_mask:0xf\n\t" \
                "v_fmac_f32_dpp %10, %10, %2 row_shr:" #N " row_mask:0xf bank_mask:0xf\n\t" "v_fmac_f32_dpp %11, %11, %3 row_shr:" #N " row_mask:0xf bank_mask:0xf\n\t" \
                "v_fmac_f32_dpp %12, %12, %4 row_shr:" #N " row_mask:0xf bank_mask:0xf\n\t" "v_fmac_f32_dpp %13, %13, %5 row_shr:" #N " row_mask:0xf bank_mask:0xf\n\t" \
                "v_fmac_f32_dpp %14, %14, %6 row_shr:" #N " row_mask:0xf bank_mask:0xf\n\t" "v_fmac_f32_dpp %15, %15, %7 row_shr:" #N " row_mask:0xf bank_mask:0xf\n\t" \
                "v_mul_f32_dpp %0, %0, %0 row_shr:" #N " row_mask:0xf bank_mask:0xf\n\t" "v_mul_f32_dpp %1, %1, %1 row_shr:" #N " row_mask:0xf bank_mask:0xf\n\t" \
                "v_mul_f32_dpp %2, %2, %2 row_shr:" #N " row_mask:0xf bank_mask:0xf\n\t" "v_mul_f32_dpp %3, %3, %3 row_shr:" #N " row_mask:0xf bank_mask:0xf\n\t" \
                "v_mul_f32_dpp %4, %4, %4 row_shr:" #N " row_mask:0xf bank_mask:0xf\n\t" "v_mul_f32_dpp %5, %5, %5 row_shr:" #N " row_mask:0xf bank_mask:0xf\n\t" \
                "v_mul_f32_dpp %6, %6, %6 row_shr:" #N " row_mask:0xf bank_mask:0xf\n\t" "v_mul_f32_dpp %7, %7, %7 row_shr:" #N " row_mask:0xf bank_mask:0xf" \
                : "+v"(A0), "+v"(A1), "+v"(A2), "+v"(A3), "+v"(A4), "+v"(A5), "+v"(A6), "+v"(A7), "+v"(B0), "+v"(B1), "+v"(B2), "+v"(B3), "+v"(B4), "+v"(B5), "+v"(B6), "+v"(B7))
#define RG_SCAN_ALL(N) do { RG_SCAN8(N, av[0], av[1], av[2], av[3], av[4], av[5], av[6], av[7], bv[0], bv[1], bv[2], bv[3], bv[4], bv[5], bv[6], bv[7]); \
                            RG_SCAN8(N, av[8], av[9], av[10], av[11], av[12], av[13], av[14], av[15], bv[8], bv[9], bv[10], bv[11], bv[12], bv[13], bv[14], bv[15]); } while (0)
            RG_SCAN_ALL(1); RG_SCAN_ALL(2); RG_SCAN_ALL(4); RG_SCAN_ALL(8);
#undef RG_SCAN_ALL
#undef RG_SCAN8
            LAS f32x2* tot = (LAS f32x2*)(lds + RG_TOT + (chunk & 1) * (8 * 64 * 8));
            if (tl == 15) {
#pragma unroll
                for (int jb = 0; jb < 4; ++jb)
#pragma unroll
                    for (int r = 0; r < 4; ++r) tot[wave * 64 + 16 * jb + 4 * kg + r] = (f32x2){av[4 * jb + r], bv[4 * jb + r]};
            }
            asm volatile("s_waitcnt lgkmcnt(0)" ::: "memory"); __builtin_amdgcn_s_barrier(); asm volatile("" ::: "memory");
#pragma unroll 1
            for (int w2 = 0; w2 < wave; ++w2) {
#pragma unroll
                for (int jb = 0; jb < 4; ++jb)
#pragma unroll
                    for (int r = 0; r < 4; ++r) { const f32x2 ab = tot[w2 * 64 + 16 * jb + 4 * kg + r]; hc[4 * jb + r] = ab.x * hc[4 * jb + r] + ab.y; }
            }
            float hin[16];
#pragma unroll
            for (int i = 0; i < 16; ++i) hin[i] = hc[i];
#pragma unroll 1
            for (int w2 = wave; w2 < 8; ++w2) {
#pragma unroll
                for (int jb = 0; jb < 4; ++jb)
#pragma unroll
                    for (int r = 0; r < 4; ++r) { const f32x2 ab = tot[w2 * 64 + 16 * jb + 4 * kg + r]; hc[4 * jb + r] = ab.x * hc[4 * jb + r] + ab.y; }
            }
            bf16_t* yr = Y + (rowb + t) * DM + cbase;
#pragma unroll
            for (int jb = 0; jb < 4; ++jb) {
                const float h0 = av[4 * jb] * hin[4 * jb] + bv[4 * jb], h1 = av[4 * jb + 1] * hin[4 * jb + 1] + bv[4 * jb + 1];
                const float h2 = av[4 * jb + 2] * hin[4 * jb + 2] + bv[4 * jb + 2], h3 = av[4 * jb + 3] * hin[4 * jb + 3] + bv[4 * jb + 3];
                u32x2 o; o.x = pg8::cvt_pk_bf16(h0 * bf_lo(gv[jb].x), h1 * bf_hi(gv[jb].x)); o.y = pg8::cvt_pk_bf16(h2 * bf_lo(gv[jb].y), h3 * bf_hi(gv[jb].y));
                *(u32x2*)(yr + 16 * jb) = o;
            }
        }
#undef RG_LOAD
    }
    __syncthreads();
}

template <int p> __device__ __forceinline__ void run_phase(LAS unsigned char* lds) {
    ArgsP ap = KA; unsigned char* ws = ap->ws;
    bf16_t* XB = (bf16_t*)(ws + WS_XB); float* SSQ = (float*)(ws + WS_SSQ); bf16_t* BIG = (bf16_t*)(ws + WS_BIG);
    const size_t MD = (size_t)M * DM;
    LAS float* RTAB = (LAS float*)(lds + 131072);
    int bx = blockIdx.x, Gn = gridDim.x; asm volatile("" : "+s"(bx), "+s"(Gn)); bx = __builtin_amdgcn_readfirstlane(bx); Gn = __builtin_amdgcn_readfirstlane(Gn);
    if constexpr (p == 0) { p0_prologue(lds); __syncthreads(); }
    else if constexpr (p == NPHASE - 1) { final_norm(ap->out, XB, SSQ, ap->in[16]); }
    else {
        constexpr int q = p - 1, layer = q / 5, k = q - 5 * layer, li = layer >> 1; constexpr bool even = (layer & 1) == 0;
        if constexpr (k == 0 || k == 3) {
            constexpr int N = (k == 3) ? FF : (even ? 3 * DM : 2 * DM), mode = (k == 3) ? 2 : (even ? 0 : 1), split = (k == 3) ? 0 : DM;
            const bf16_t* Bt = (k == 3) ? (const bf16_t*)(ws + WS_W1) + (size_t)layer * DM * FF : even ? (const bf16_t*)(ws + WS_WQKV) + (size_t)li * DM * 3 * DM : (const bf16_t*)(ws + WS_WIN) + (size_t)li * DM * 2 * DM;
            pg8::Gemm g{XB, Bt, M, N, DM}; pg8::FastOrder S; S.init(M, N, Gn, bx);
            pg8::EpiAct E{BIG, split ? DM : FF, split, MD, RTAB, mode, SSQ};
            pg8::gemm_phase<pg8::EpiAct, pg8::FastOrder, true, true>(lds, g, S, E);
        } else if constexpr (k == 2 || k == 4) {
            constexpr int K = (k == 4) ? FF : DM;
            const bf16_t* A = (k == 4) ? BIG : even ? BIG + 3 * MD : BIG + 2 * MD;
            const bf16_t* Bt = (k == 4) ? (const bf16_t*)(ws + WS_W2) + (size_t)layer * DM * FF : even ? (const bf16_t*)(ws + WS_WO) + (size_t)li * DM * DM : (const bf16_t*)(ws + WS_WRO) + (size_t)li * DM * DM;
            pg8::Gemm g{A, Bt, M, DM, K}; pg8::FastOrder S; S.init(M, DM, Gn, bx);
            pg8::EpiRes E{ws, WS_XB, WS_SSQ};
            pg8::gemm_phase<pg8::EpiRes, pg8::FastOrder, false, true>(lds, g, S, E);
        } else if constexpr (even) {
            attn_phase(lds, BIG, BIG + MD, BIG + 2 * MD, BIG + 3 * MD); __syncthreads();
        } else {
            rg_phase(lds, li);
        }
    }
}
constexpr int MISC_OFF = 131072 + 4096;
constexpr size_t WS_BAR = 0;
template <int p> __device__ __forceinline__ void run_from(LAS unsigned char* lds, cg::grid_group& grid) {
    if constexpr (p < NPHASE) {
        const int lo = KA->ph_lo, hi = KA->ph_hi;
        if (lo <= p && p < hi) {
#if defined(PROBE_DUP)
            if constexpr (p == PROBE_DUP) { for (int rep = 0; rep < PROBE_REPS; ++rep) { run_phase<p>(lds); grid.sync(); } }
#endif
            run_phase<p>(lds);
            if (p + 1 < hi) {
                if (hi > NPHASE) grid.sync();
                { XcdBarrier bar; bar.bar = (unsigned*)(KA->ws + WS_BAR); bar.x = xb_xcc_id(); bar.st = (volatile LAS unsigned*)(lds + MISC_OFF); xcd_barrier(bar); }
            }
        }
        run_from<p + 1>(lds, grid);
    }
}
__global__ void __launch_bounds__(NWAVES * 64, 2) hybrid_fwd(Args args_unused) {
    extern __shared__ __attribute__((aligned(16))) unsigned char lds_raw[];
    LAS unsigned char* lds = (LAS unsigned char*)lds_raw;
    cg::grid_group grid = cg::this_grid();
    if (threadIdx.x < 2) ((volatile LAS unsigned*)(lds + MISC_OFF))[threadIdx.x] = 0u;
    __syncthreads();
    if (KA->ph_hi - KA->ph_lo > 2) (void)xcd_barrier_post((unsigned*)(KA->ws + WS_BAR), (volatile LAS unsigned*)(lds + MISC_OFF));
    run_from<0>(lds, grid);
}

extern "C" void kernel_launch(void* const* d_in, const int* in_sizes, int n_in, void* d_out, int out_size, void* d_ws, size_t ws_size, hipStream_t stream) {
    static int grid = 0;
    if (grid == 0) {
        if (n_in != 17 || in_sizes[0] != M * DM || out_size != M * DM || ws_size < WS_END) { fprintf(stderr, "kernel_launch: unexpected shapes (n_in %d, in0 %d, out %d, ws %zu); nothing launched\n", n_in, n_in > 0 ? in_sizes[0] : -1, out_size, ws_size); grid = -1; return; }
        int dev = 0, cus = 0, per_cu = 0;
        if (hipGetDevice(&dev) != hipSuccess || hipDeviceGetAttribute(&cus, hipDeviceAttributeMultiprocessorCount, dev) != hipSuccess) { grid = -1; return; }
        if (hipFuncSetAttribute((const void*)hybrid_fwd, hipFuncAttributeMaxDynamicSharedMemorySize, LDS_BYTES) != hipSuccess) { fprintf(stderr, "kernel_launch: hipFuncSetAttribute failed\n"); grid = -1; return; }
        if (hipOccupancyMaxActiveBlocksPerMultiprocessor(&per_cu, (const void*)hybrid_fwd, NWAVES * 64, LDS_BYTES) != hipSuccess || per_cu < 1) { fprintf(stderr, "kernel_launch: occupancy query says %d\n", per_cu); per_cu = 1; }
        (void)hipGetLastError();
        grid = cus * per_cu;
    }
    if (grid < 0) return;
    Args a{};
    for (int i = 0; i < 17; ++i) a.in[i] = (const float*)d_in[i];
    a.out = (float*)d_out; a.ws = (unsigned char*)d_ws;
#if MK_ONE_LAUNCH
    a.ph_lo = 0; a.ph_hi = NPHASE;
    if (hipMemsetAsync((char*)d_ws + WS_BAR, 0, 16384, stream) != hipSuccess) { fprintf(stderr, "kernel_launch: hipMemsetAsync failed\n"); return; }
    { void* kargs[] = {&a}; hipError_t e = hipLaunchCooperativeKernel((const void*)hybrid_fwd, dim3(grid), dim3(NWAVES * 64), kargs, LDS_BYTES, stream);
      if (e != hipSuccess) fprintf(stderr, "cooperative launch failed: %s (grid %d)\n", hipGetErrorString(e), grid); }
#else
    for (int p = 0; p < NPHASE; ++p) {
        a.ph_lo = p; a.ph_hi = p + 1;
        void* kargs[] = {&a}; hipError_t e = hipLaunchCooperativeKernel((const void*)hybrid_fwd, dim3(grid), dim3(NWAVES * 64), kargs, LDS_BYTES, stream);
        if (e != hipSuccess) { fprintf(stderr, "launch %d failed: %s (grid %d)\n", p, hipGetErrorString(e), grid); break; }
    }
#endif
}
```
